# Optimizing an MI355X kernel written in HIP

```python
import jax, jax.numpy as jnp
from jax import lax
import numpy as np

D_MODEL = 2048
BATCH = 2
SEQ = 8192
DEPTH = 1

CHUNK = 64
N_META = 16
Q_BLOCK = 128
SB_HEADS = 8
SB_HEAD_DIM = 128
SB_WIDTH = SB_HEADS * SB_HEAD_DIM
SB_SCALE = SB_HEAD_DIM ** -0.5
MLA_HEADS = 16
MLA_NOPE_DIM = 128
MLA_ROPE_DIM = 64
MLA_V_DIM = 128
MLA_KV_RANK = 512
MLA_QK_DIM = MLA_NOPE_DIM + MLA_ROPE_DIM
MLA_SCALE = MLA_QK_DIM ** -0.5
ROPE_THETA = 10000.0
IN_SPLITS = (SB_WIDTH, SB_WIDTH, SB_WIDTH, MLA_HEADS * MLA_QK_DIM, MLA_KV_RANK, MLA_ROPE_DIM, D_MODEL, D_MODEL)
IN_WIDTH = SB_WIDTH * 3 + MLA_HEADS * MLA_QK_DIM + MLA_KV_RANK + MLA_ROPE_DIM + 2 * D_MODEL
N_GROUPS = 4
EXPERTS_PER_GROUP = 8
N_EXPERTS = N_GROUPS * EXPERTS_PER_GROUP
TOP_K = 2
EXPERT_FF = 1024
ROUTE_BLOCK = 256
RMS_EPS = 1e-6

kernel_name = "hybrid_stickbreak_mla_hmoe_block"


def rms_norm(x, g):
    xf = x.astype(jnp.float32)
    y = xf * lax.rsqrt(jnp.mean(xf * xf, axis=-1, keepdims=True) + RMS_EPS)
    return (y * g.astype(jnp.float32)).astype(x.dtype)


def rope(x, pos):
    half = MLA_ROPE_DIM // 2
    inv = ROPE_THETA ** (-jnp.arange(half, dtype=jnp.float32) / half)
    ang = pos.astype(jnp.float32)[:, None] * inv[None, :]
    cos = jnp.cos(ang).astype(x.dtype)
    sin = jnp.sin(ang).astype(x.dtype)
    x1, x2 = x[..., :half], x[..., half:]
    return jnp.concatenate([x1 * cos - x2 * sin, x1 * sin + x2 * cos], axis=-1)


def to_blocks(t):
    b, h, lp, d = t.shape
    return t.reshape(b, h, lp // Q_BLOCK, Q_BLOCK, d).transpose(2, 0, 1, 3, 4)


def from_blocks(t):
    nb, b, h, qb, d = t.shape
    return t.transpose(1, 2, 0, 3, 4).reshape(b, h, nb * qb, d)


def stick_breaking_attention(q, k, v, idx):
    nb = q.shape[2] // Q_BLOCK
    def one(args):
        qb, qpos = args
        z = jnp.einsum('bhqd,bhkd->bhqk', qb, k).astype(jnp.float32) * SB_SCALE
        causal = idx[None, :] < qpos[:, None]
        log_1m = jnp.where(causal, jax.nn.log_sigmoid(-z), 0.0)
        log_w = jax.nn.log_sigmoid(z) + lax.cumsum(log_1m, axis=3, reverse=True) - log_1m
        a = jnp.where(causal, jnp.exp(log_w), 0.0)
        return jnp.einsum('bhqk,bhkd->bhqd', a.astype(v.dtype), v)
    o = lax.map(one, (to_blocks(q), idx.reshape(nb, Q_BLOCK)))
    return from_blocks(o)


def latent_attention(q_nope, q_rope, k_nope, k_rope, v, chunk):
    nb = q_nope.shape[2] // Q_BLOCK
    def one(args):
        qn, qr, qc = args
        s = (jnp.einsum('bhqd,bhkd->bhqk', qn, k_nope)
             + jnp.einsum('bhqr,bkr->bhqk', qr, k_rope)).astype(jnp.float32) * MLA_SCALE
        mask = chunk[None, :] <= qc[:, None]
        p = jax.nn.softmax(jnp.where(mask, s, -jnp.inf), axis=-1)
        return jnp.einsum('bhqk,bhkd->bhqd', p.astype(v.dtype), v)
    o = lax.map(one, (to_blocks(q_nope), to_blocks(q_rope), chunk.reshape(nb, Q_BLOCK)))
    return from_blocks(o)


def hybrid_mixer(hn, w_in, b_gate, kv_norm_g, w_uk, w_uv, w_proj_a, w_proj_b, w_out):
    b, l, _ = hn.shape
    lp = -(-l // Q_BLOCK) * Q_BLOCK
    hp = jnp.pad(hn, ((0, 0), (0, lp - l), (0, 0)))
    idx = jnp.arange(lp)
    chunk = jnp.where(idx < N_META, 0, 1 + (idx - N_META) // CHUNK)
    offs = [sum(IN_SPLITS[:i + 1]) for i in range(len(IN_SPLITS) - 1)]
    sb_q, sb_k, sb_v, mla_q, c_kv, k_rope, g_a, g_b = jnp.split(hp @ w_in, offs, axis=-1)

    def heads(t, h):
        return t.reshape(b, lp, h, -1).transpose(0, 2, 1, 3)

    o_a = stick_breaking_attention(heads(sb_q, SB_HEADS), heads(sb_k, SB_HEADS), heads(sb_v, SB_HEADS), idx)

    q = heads(mla_q, MLA_HEADS)
    q_nope, q_rope = q[..., :MLA_NOPE_DIM], rope(q[..., MLA_NOPE_DIM:], idx)
    k_rope = rope(k_rope, idx)
    c = rms_norm(c_kv, kv_norm_g)
    k_nope = heads(c @ w_uk, MLA_HEADS)
    v = heads(c @ w_uv, MLA_HEADS)
    o_b = latent_attention(q_nope, q_rope, k_nope, k_rope, v, chunk)

    def flat(o):
        return o.transpose(0, 2, 1, 3).reshape(b, lp, -1)[:, :l]

    bg_a, bg_b = jnp.split(b_gate, 2)
    y = (jax.nn.sigmoid(g_a[:, :l] + bg_a) * (flat(o_a) @ w_proj_a)
         + jax.nn.sigmoid(g_b[:, :l] + bg_b) * (flat(o_b) @ w_proj_b))
    return y @ w_out


def hierarchical_moe(hn, w_route_group, b_route_group, w_route_expert, b_route_expert, w1, w3, w2):
    n, d = hn.shape
    g_logits = (hn @ w_route_group).astype(jnp.float32) + b_route_group.astype(jnp.float32)
    g_prob = jax.nn.softmax(g_logits, axis=-1)
    g_sel = jnp.argmax(g_logits, axis=-1)
    p_g = jnp.take_along_axis(g_prob, g_sel[:, None], axis=-1)
    e_logits = ((hn @ w_route_expert).astype(jnp.float32)
                + b_route_expert.astype(jnp.float32)).reshape(n, N_GROUPS, EXPERTS_PER_GROUP)
    e_in_group = jnp.take_along_axis(e_logits, g_sel[:, None, None], axis=1)[:, 0]
    top_v, top_i = lax.top_k(jax.nn.softmax(e_in_group, axis=-1), TOP_K)
    weights = p_g * top_v / jnp.sum(top_v, axis=-1, keepdims=True)
    expert_id = g_sel[:, None] * EXPERTS_PER_GROUP + top_i

    m = n * TOP_K
    flat_e = expert_id.reshape(m)
    flat_w = weights.reshape(m).astype(hn.dtype)
    flat_t = jnp.arange(m) // TOP_K
    order = jnp.argsort(flat_e)
    se, st, sw = flat_e[order], flat_t[order], flat_w[order]
    counts = jnp.bincount(flat_e, length=N_EXPERTS)
    padded = (counts + ROUTE_BLOCK - 1) // ROUTE_BLOCK * ROUTE_BLOCK
    starts = jnp.cumsum(counts) - counts
    pends = jnp.cumsum(padded)
    pstarts = pends - padded
    dest = pstarts[se] + jnp.arange(m) - starts[se]
    n_blocks = (m + N_EXPERTS * (ROUTE_BLOCK - 1) + ROUTE_BLOCK - 1) // ROUTE_BLOCK
    p_rows = n_blocks * ROUTE_BLOCK
    buf_t = jnp.zeros((p_rows,), jnp.int32).at[dest].set(st.astype(jnp.int32))
    buf_w = jnp.zeros((p_rows,), hn.dtype).at[dest].set(sw)
    block_e = jnp.clip(jnp.searchsorted(pends, jnp.arange(n_blocks) * ROUTE_BLOCK, side='right'), 0, N_EXPERTS - 1)

    def expert_block(args):
        tok, w, e = args
        xb = hn[tok]
        hid = jax.nn.silu(xb @ w1[e]) * (xb @ w3[e])
        return (hid @ w2[e]) * w[:, None]
    y = lax.map(expert_block, (buf_t.reshape(n_blocks, ROUTE_BLOCK), buf_w.reshape(n_blocks, ROUTE_BLOCK), block_e))
    return jnp.zeros_like(hn).at[buf_t].add(y.reshape(p_rows, d))


def setup_inputs(seed: int = 0) -> dict:
    key = jax.random.key(seed)
    ks = jax.random.split(key, 20)
    f32 = jnp.float32

    def nrm(k, shape, fan_in):
        return jax.random.normal(k, shape, f32) * (fan_in ** -0.5)

    def gain(k, shape):
        return 1.0 + 0.02 * jax.random.normal(k, shape, f32)

    return {
        "x": jax.random.normal(ks[0], (BATCH, SEQ, D_MODEL), f32),
        "meta_tokens": jax.random.normal(ks[1], (N_META, D_MODEL), f32),
        "norm1_g": gain(ks[2], (DEPTH, D_MODEL)),
        "w_in": nrm(ks[3], (DEPTH, D_MODEL, IN_WIDTH), D_MODEL),
        "b_gate": 0.02 * jax.random.normal(ks[4], (DEPTH, 2 * D_MODEL), f32),
        "kv_norm_g": gain(ks[5], (DEPTH, MLA_KV_RANK)),
        "w_uk": nrm(ks[6], (DEPTH, MLA_KV_RANK, MLA_HEADS * MLA_NOPE_DIM), MLA_KV_RANK),
        "w_uv": nrm(ks[7], (DEPTH, MLA_KV_RANK, MLA_HEADS * MLA_V_DIM), MLA_KV_RANK),
        "w_proj_a": nrm(ks[8], (DEPTH, SB_WIDTH, D_MODEL), SB_WIDTH),
        "w_proj_b": nrm(ks[9], (DEPTH, MLA_HEADS * MLA_V_DIM, D_MODEL), MLA_HEADS * MLA_V_DIM),
        "w_out": nrm(ks[10], (DEPTH, D_MODEL, D_MODEL), D_MODEL),
        "norm2_g": gain(ks[11], (DEPTH, D_MODEL)),
        "w_route_group": nrm(ks[12], (DEPTH, D_MODEL, N_GROUPS), D_MODEL),
        "b_route_group": 0.01 * jax.random.normal(ks[13], (DEPTH, N_GROUPS), f32),
        "w_route_expert": nrm(ks[14], (DEPTH, D_MODEL, N_EXPERTS), D_MODEL),
        "b_route_expert": 0.01 * jax.random.normal(ks[15], (DEPTH, N_EXPERTS), f32),
        "w1": nrm(ks[16], (DEPTH, N_EXPERTS, D_MODEL, EXPERT_FF), D_MODEL),
        "w3": nrm(ks[17], (DEPTH, N_EXPERTS, D_MODEL, EXPERT_FF), D_MODEL),
        "w2": nrm(ks[18], (DEPTH, N_EXPERTS, EXPERT_FF, D_MODEL), EXPERT_FF),
        "final_g": gain(ks[19], (D_MODEL,)),
    }


def reference(x, meta_tokens, norm1_g, w_in, b_gate, kv_norm_g, w_uk, w_uv, w_proj_a, w_proj_b, w_out,
              norm2_g, w_route_group, b_route_group, w_route_expert, b_route_expert, w1, w3, w2, final_g):
    b = x.shape[0]
    meta = jnp.broadcast_to(meta_tokens.astype(x.dtype)[None], (b, N_META, x.shape[-1]))
    h = jnp.concatenate([meta, x], axis=1)
    for l in range(DEPTH):
        h = h + hybrid_mixer(rms_norm(h, norm1_g[l]), w_in[l], b_gate[l], kv_norm_g[l], w_uk[l], w_uv[l],
                             w_proj_a[l], w_proj_b[l], w_out[l])
        hn = rms_norm(h, norm2_g[l])
        ffn = hierarchical_moe(hn.reshape(-1, hn.shape[-1]), w_route_group[l], b_route_group[l],
                               w_route_expert[l], b_route_expert[l], w1[l], w3[l], w2[l])
        h = h + ffn.reshape(h.shape)
    return rms_norm(h, final_g)[:, N_META:]
```

```cpp
#define MLA_DMA 1
#include <hip/hip_runtime.h>
#include <cstdio>
#include <cstdint>

#define GAS __attribute__((address_space(1)))
#define LAS __attribute__((address_space(3)))
typedef unsigned short bf16;
typedef short bf16x8 __attribute__((ext_vector_type(8)));
typedef float f32x4 __attribute__((ext_vector_type(4)));
typedef float f32x2 __attribute__((ext_vector_type(2)));
typedef unsigned u32x4 __attribute__((ext_vector_type(4)));
typedef unsigned u32x2 __attribute__((ext_vector_type(2)));
typedef GAS unsigned gu32;
#define RLX_AGENT __ATOMIC_RELAXED, __HIP_MEMORY_SCOPE_AGENT
#define LDS_WAIT() asm volatile("s_waitcnt lgkmcnt(0)" ::: "memory")
#define VM_WAIT() asm volatile("s_waitcnt vmcnt(0)" ::: "memory")

constexpr int DM = 2048, NB = 2, SEQ = 8192, NMETA = 16;
constexpr int M = NB * SEQ;
constexpr int MR = M + 256;
constexpr int NIN = 11008;
constexpr int C_SBK = 1024, C_SBV = 2048, C_QN = 3072, C_QR = 5120, C_CKV = 6144, C_GATE = 6656, C_KR = 10752, C_END = 10816;
constexpr int NE = 32, FF = 1024, MAXSLOT = 40960, MAXTILES = 160;
constexpr float LOG2E = 1.4426950408889634f;
constexpr float SB_QS = 0.08838834764831845f * LOG2E;
constexpr float MLA_QS = 0.07216878364870323f * LOG2E;
constexpr float RMS_EPS = 1e-6f;

constexpr size_t MiB = 1u << 20;
constexpr size_t WS_CTL = 0, CTL_ZERO_BYTES = 1 * MiB;
constexpr size_t WS_ROPE = 1 * MiB;
constexpr size_t WS_WR = 3 * MiB + 256 * 1024;
constexpr size_t WS_SEL = 3 * MiB + 768 * 1024;
constexpr size_t WS_WTS = WS_SEL + 131072;
constexpr size_t WS_POS = WS_WTS + 131072;
constexpr size_t WS_SLOT = WS_POS + 131072;
constexpr size_t WS_RS2 = WS_SLOT + 131072;
constexpr size_t WS_TT = WS_RS2 + 65536;
constexpr size_t WS_SSQP = 934 * MiB;
constexpr size_t WS_RSS = WS_TT + 1024;
constexpr size_t WS_W13 = 5 * MiB;
constexpr size_t WS_W2 = 261 * MiB;
constexpr size_t WS_WOUT = 389 * MiB;
constexpr size_t WS_WPROJ = 397 * MiB;
constexpr size_t WS_WKV = 409 * MiB;
constexpr size_t WS_WIN = 413 * MiB;
constexpr size_t WS_HN = 456 * MiB;
constexpr size_t WS_KN = WS_HN, WS_Y = WS_HN;
constexpr size_t WS_VV = 521 * MiB;
constexpr size_t WS_H1B = WS_VV;
constexpr size_t WS_QCAT = 586 * MiB;
constexpr size_t WS_SBK = 684 * MiB;
constexpr size_t WS_SBV = 717 * MiB;
constexpr size_t WS_QR = 750 * MiB;
constexpr size_t WS_CKV = 783 * MiB;
constexpr size_t WS_KR = 800 * MiB;
constexpr size_t WS_GATE = 803 * MiB;
constexpr size_t WS_XS = 586 * MiB;
constexpr size_t WS_HID = 746 * MiB;
constexpr size_t WS_YS = 826 * MiB;
constexpr size_t WS_END = 986 * MiB;
constexpr int CW_TMO = 0, CW_CODE = 1, CW_NT = 2, CW_CNT = 64, CW_BAR = 4096, CW_SSQ = 65536;

constexpr int CW_BGQ = 8192;
constexpr int CW_STOK = 147456;
constexpr int NWAVES = 8;
constexpr int RING_BYTES = 131072, LDSCTL_OFF = RING_BYTES, MISC_OFF = LDSCTL_OFF + 320, LDS_BYTES = 163840;

typedef __bf16 bf16x2_t __attribute__((ext_vector_type(2)));
__device__ __forceinline__ unsigned cvt_pk_bf16(float lo, float hi) { f32x2 v = {lo, hi}; bf16x2_t b = __builtin_convertvector(v, bf16x2_t); return __builtin_bit_cast(unsigned, b); }
__device__ __forceinline__ float bflo(unsigned w) { return __uint_as_float(w << 16); }
__device__ __forceinline__ float bfhi(unsigned w) { return __uint_as_float(w & 0xffff0000u); }
__device__ __forceinline__ float bf2f(bf16 b) { return __uint_as_float((unsigned)b << 16); }
__device__ __forceinline__ float wave_sum(float v) {
#pragma unroll
    for (int o = 1; o < 64; o <<= 1) v += __shfl_xor(v, o);
    return v;
}
__device__ __forceinline__ float wave_max(float v) {
#pragma unroll
    for (int o = 1; o < 64; o <<= 1) v = fmaxf(v, __shfl_xor(v, o));
    return v;
}

#define XB_TMO      128
#define XB_XCNT(j)  (256  + 64 * (j))
#define XB_XSUB(j)  (1280 + 64 * (j))
#define XB_XGEN(j)  (2304 + 64 * (j))
#define XB_TOP      3328
#define XB_TOPGEN   3392
#define XCD_BAR_WORDS 3456
#define XB_SPIN_CAP (1u << 22)
__device__ __forceinline__ unsigned xb_ld(unsigned* p)              { return __hip_atomic_load(p, __ATOMIC_RELAXED, __HIP_MEMORY_SCOPE_AGENT); }
__device__ __forceinline__ unsigned xb_add(unsigned* p, unsigned v) { return __hip_atomic_fetch_add(p, v, __ATOMIC_RELAXED, __HIP_MEMORY_SCOPE_AGENT); }
__device__ __forceinline__ unsigned xb_xcc_id() { return (unsigned)__builtin_amdgcn_s_getreg((3 << 11) | 20) & 0xFu; }
#define XB_SPIN(cond, bar) do { unsigned _sp = 0; while (cond) { __builtin_amdgcn_s_sleep(1); \
    if ((++_sp & 255u) == 0u) { if (xb_ld(&(bar)[XB_TMO])) break; if (_sp > XB_SPIN_CAP) { atomicAdd(&(bar)[XB_TMO], 1u); break; } } } } while (0)
struct XcdBarrier { unsigned* bar; unsigned x; volatile LAS unsigned* st; };
__device__ __forceinline__ XcdBarrier xcd_barrier_post(unsigned* bar, volatile LAS unsigned* st) {
    XcdBarrier b; b.bar = bar; b.x = xb_xcc_id(); b.st = st;
    if (threadIdx.x == 0) (void)xb_add(&bar[XB_XCNT(b.x)], 1u);
    return b;
}
__device__ __forceinline__ void xcd_barrier_complete(unsigned* bar, unsigned x, unsigned& nloc, unsigned& nx) {
    const unsigned G = gridDim.x * gridDim.y * gridDim.z;
    unsigned sum, cnt, mine, sp = 0u;
    for (;;) {
        sum = 0u; cnt = 0u; mine = 0u;
#pragma unroll
        for (unsigned j = 0; j < 16; ++j) { const unsigned c = xb_ld(&bar[XB_XCNT(j)]); sum += c; cnt += (c > 0u) ? 1u : 0u; mine = (j == x) ? c : mine; }
        if (sum == G) break;
        __builtin_amdgcn_s_sleep(1);
        if ((++sp & 255u) == 0u) { if (xb_ld(&bar[XB_TMO])) break; if (sp > XB_SPIN_CAP) { atomicAdd(&bar[XB_TMO], 1u); break; } }
    }
    nloc = mine > 0u ? mine : 1u; nx = cnt > 0u ? cnt : 1u;
}
__device__ __forceinline__ void xcd_barrier(const XcdBarrier& b) {
    asm volatile("s_waitcnt vmcnt(0)" ::: "memory");
    __syncthreads();
    if (threadIdx.x == 0) {
        unsigned* bar = b.bar;
        __builtin_amdgcn_s_waitcnt(0);
        unsigned nloc = b.st[0], nx = b.st[1];
        if (nloc == 0u) { xcd_barrier_complete(bar, b.x, nloc, nx); b.st[0] = nloc; b.st[1] = nx; }
        const unsigned old = xb_add(&bar[XB_XSUB(b.x)], 1u);
        const unsigned gen = old / nloc;
        if (old + 1u == (gen + 1u) * nloc) {
            __builtin_amdgcn_fence(__ATOMIC_RELEASE, "agent");
            asm volatile("s_waitcnt vmcnt(0)" ::: "memory");
            const unsigned og = xb_add(&bar[XB_TOP], 1u);
            const unsigned tg = og / nx;
            if (og + 1u == (tg + 1u) * nx) xb_add(&bar[XB_TOPGEN], 1u);
            else XB_SPIN(xb_ld(&bar[XB_TOPGEN]) == tg, bar);
            __builtin_amdgcn_fence(__ATOMIC_ACQUIRE, "agent");
            xb_add(&bar[XB_XGEN(b.x)], 1u);
            asm volatile("s_waitcnt vmcnt(0)" ::: "memory");
        } else {
            XB_SPIN(xb_ld(&bar[XB_XGEN(b.x)]) == gen, bar);
            __builtin_amdgcn_fence(__ATOMIC_ACQUIRE, "agent");
            asm volatile("s_waitcnt vmcnt(0)" ::: "memory");
        }
    }
    __syncthreads();
}

struct Args { const float* in[20]; float* out; unsigned char* ws; int ph_lo, ph_hi; };
#define WSP(T, off) ((T*)(C.a->ws + (off)))
struct Ctx {
    LAS unsigned char* lds;
    int tid, wave, gw, ngw;
    __device__ __forceinline__ int ln() const { int t = threadIdx.x; asm volatile("" : "+v"(t)); return t & 63; }
    const Args* a;
    __device__ __forceinline__ const float* in(int i) const { return a->in[i]; }
    __device__ __forceinline__ float* out() const { return a->out; }
    __device__ __forceinline__ unsigned* ctl() const { return (unsigned*)(a->ws + WS_CTL); }
    __device__ __forceinline__ float* SSQ() const { return (float*)(a->ws + WS_CTL) + CW_SSQ; }
};
enum { I_X = 0, I_META, I_N1G, I_WIN, I_BGATE, I_KVG, I_WUK, I_WUV, I_WPA, I_WPB, I_WOUT, I_N2G, I_WRG, I_BRG, I_WRE, I_BRE, I_W1, I_W3, I_W2, I_FG };

__device__ __forceinline__ int win_src(int n) {
    if (n < C_QN) return n;
    if (n < C_QR) { const int t = n - C_QN; return 3072 + (t >> 7) * 192 + (t & 127); }
    if (n < C_CKV) { const int t = n - C_QR, h = t >> 6, p = t & 63; return 3072 + h * 192 + 128 + (p & 1) * 32 + (p >> 1); }
    if (n < C_GATE) return n;
    if (n < C_KR) return n + 64;
    if (n < C_END) { const int p = n - C_KR; return 6656 + (p & 1) * 32 + (p >> 1); }
    return -1;
}
struct SrcWin { const float* W; __device__ __forceinline__ float get(int k, int n) const { const int s = win_src(n); return s < 0 ? 0.f : W[(size_t)k * 10816 + s]; } };
struct SrcKV { const float *uk, *uv, *g; __device__ __forceinline__ float get(int k, int n) const { return (n < 2048 ? uk[(size_t)k * 2048 + n] : uv[(size_t)k * 2048 + n - 2048]) * g[k]; } };
struct SrcPlain { const float* W; int N; __device__ __forceinline__ float get(int k, int n) const { return W[(size_t)k * N + n]; } };
struct SrcW13 { const float *w1, *w3, *g; __device__ __forceinline__ float get(int k, int n) const { const int f = 4 * (n >> 3) + (n & 3); const long long d = (n & 4) ? ((const char*)w3 - (const char*)w1) : 0ll;
        return *(const float*)((const char*)(w1 + (size_t)k * FF + f) + d) * g[k]; } };

template <class Src>
__device__ __forceinline__ void tr_matrix(const Src& S, int K, int N, bf16* WT, size_t ldd, LAS float* scr, int gw, int ngw, int lane) {
    const int nblk = N / 32, nitems = (K / 64) * nblk;
    for (int it = gw; it < nitems; it += ngw) {
        const int kb = it / nblk, nb = it % nblk, k0 = 64 * kb, n0 = 32 * nb;
#pragma unroll 8
        for (int i = 0; i < 32; ++i) { const int kk = 2 * i + (lane >> 5); scr[kk * 33 + (lane & 31)] = S.get(k0 + kk, n0 + (lane & 31)); }
        LDS_WAIT(); asm volatile("" ::: "memory");
        const int c = lane & 7;
#pragma unroll
        for (int j = 0; j < 4; ++j) { const int n = (lane >> 3) + 8 * j; const LAS float* s = scr + (8 * c) * 33 + n;
            u32x4 o; o.x = cvt_pk_bf16(s[0 * 33], s[1 * 33]); o.y = cvt_pk_bf16(s[2 * 33], s[3 * 33]); o.z = cvt_pk_bf16(s[4 * 33], s[5 * 33]); o.w = cvt_pk_bf16(s[6 * 33], s[7 * 33]);
            *(u32x4*)(WT + (size_t)(n0 + n) * ldd + k0 + 8 * c) = o; }
        LDS_WAIT(); asm volatile("" ::: "memory");
    }
}
__device__ __forceinline__ void rms_row_to_bf16(const float* xrow, const float* g, bf16* orow, int lane) {
    const f32x4* xr = (const f32x4*)xrow + lane; const f32x4* gr = (const f32x4*)g + lane;
    f32x4 v[8]; float s = 0.f;
#pragma unroll
    for (int j = 0; j < 8; ++j) { v[j] = xr[64 * j]; s += (v[j].x * v[j].x + v[j].y * v[j].y) + (v[j].z * v[j].z + v[j].w * v[j].w); }
    const float rstd = 1.f / sqrtf(wave_sum(s) * (1.f / DM) + RMS_EPS);
    u32x2* o8 = (u32x2*)orow + lane;
#pragma unroll
    for (int j = 0; j < 8; ++j) { const f32x4 gg = gr[64 * j]; u32x2 w; w.x = cvt_pk_bf16(v[j].x * rstd * gg.x, v[j].y * rstd * gg.y); w.y = cvt_pk_bf16(v[j].z * rstd * gg.z, v[j].w * rstd * gg.w); o8[64 * j] = w; }
}
__device__ __forceinline__ int win_dst(int s) {
    if (s < 3072) return s;
    if (s < 6144) { const int t = s - 3072, h = t / 192, d = t - h * 192; if (d < 128) return C_QN + h * 128 + d; const int j = d - 128; return C_QR + h * 64 + 2 * (j & 31) + (j >> 5); }
    if (s < 6656) return s;
    if (s < 6720) { const int j = s - 6656; return C_KR + 2 * (j & 31) + (j >> 5); }
    return s - 64;
}
__device__ __forceinline__ int tr_dst(int kind, int roff, int s) { return kind == 1 ? win_dst(s) : kind == 2 ? 8 * (s >> 2) + (s & 3) + roff : s + roff; }
__device__ __forceinline__ void tr_unit(const float* W, int N, const float* g, bf16* WT, int ldd, int kind, int roff, int sblk, int k0, int lane, LAS float* scr, int sub_lo = 0, int sub_hi = 8) {
    const int kq = lane >> 3, n4 = lane & 7, c = lane & 7;
    for (int sub = sub_lo; sub < sub_hi; ++sub) {
        const int s0 = sblk * 256 + sub * 32;
        if (s0 >= N) break;
        const float* wp = W + (size_t)(k0 + kq) * N + s0 + 4 * n4;
        f32x4 v[8];
#pragma unroll
        for (int i = 0; i < 8; ++i) v[i] = *(const f32x4*)(wp + (size_t)(8 * i) * N);
        if (g) {
#pragma unroll
            for (int i = 0; i < 8; ++i) v[i] = v[i] * g[k0 + kq + 8 * i];
        }
#pragma unroll
        for (int i = 0; i < 8; ++i) *(LAS f32x4*)(scr + (kq + 8 * i) * 32 + ((4 * n4) ^ (4 * i))) = v[i];
        LDS_WAIT(); asm volatile("" ::: "memory");
#pragma unroll
        for (int j = 0; j < 4; ++j) { const int si = (lane >> 3) + 8 * j; const LAS float* p = scr + (8 * c) * 32 + (si ^ (4 * c));
            u32x4 o; o.x = cvt_pk_bf16(p[0 * 32], p[1 * 32]); o.y = cvt_pk_bf16(p[2 * 32], p[3 * 32]); o.z = cvt_pk_bf16(p[4 * 32], p[5 * 32]); o.w = cvt_pk_bf16(p[6 * 32], p[7 * 32]);
            *(u32x4*)(WT + (size_t)tr_dst(kind, roff, s0 + si) * ldd + k0 + 8 * c) = o; }
        LDS_WAIT(); asm volatile("" ::: "memory");
    }
}
constexpr int U_WIN = 43 * 32, U_UK = 8 * 8, U_PA = 8 * 16, U_PB = 8 * 32, U_OUT = 8 * 32, U_W1 = NE * 4 * 32, U_W2 = NE * 8 * 16;
constexpr int UO_UK = U_WIN, UO_UV = UO_UK + U_UK, UO_PA = UO_UV + U_UK, UO_PB = UO_PA + U_PA, UO_OUT = UO_PB + U_PB, UO_W1 = UO_OUT + U_OUT, UO_W3 = UO_W1 + U_W1, UO_W2 = UO_W3 + U_W1, U_TOTAL = UO_W2 + U_W2;
__device__ __forceinline__ void tr_dispatch(const Ctx& C, int u, int lane, LAS float* scr, int sub_lo = 0, int sub_hi = 8) {
    if (u < UO_UK) { tr_unit(C.in(I_WIN), 10816, nullptr, WSP(bf16, WS_WIN), 2048, 1, 0, u >> 5, (u & 31) * 64, lane, scr, sub_lo, sub_hi); return; }
    if (u < UO_UV) { const int t = u - UO_UK; tr_unit(C.in(I_WUK), 2048, C.in(I_KVG), WSP(bf16, WS_WKV), 512, 0, 0, t >> 3, (t & 7) * 64, lane, scr, sub_lo, sub_hi); return; }
    if (u < UO_PA) { const int t = u - UO_UV; tr_unit(C.in(I_WUV), 2048, C.in(I_KVG), WSP(bf16, WS_WKV), 512, 0, 2048, t >> 3, (t & 7) * 64, lane, scr, sub_lo, sub_hi); return; }
    if (u < UO_PB) { const int t = u - UO_PA; tr_unit(C.in(I_WPA), 2048, nullptr, WSP(bf16, WS_WPROJ), 3072, 0, 0, t >> 4, (t & 15) * 64, lane, scr, sub_lo, sub_hi); return; }
    if (u < UO_OUT) { const int t = u - UO_PB; tr_unit(C.in(I_WPB), 2048, nullptr, WSP(bf16, WS_WPROJ) + 1024, 3072, 0, 0, t >> 5, (t & 31) * 64, lane, scr, sub_lo, sub_hi); return; }
    if (u < UO_W1) { const int t = u - UO_OUT; tr_unit(C.in(I_WOUT), 2048, nullptr, WSP(bf16, WS_WOUT), 2048, 0, 0, t >> 5, (t & 31) * 64, lane, scr, sub_lo, sub_hi); return; }
    if (u < UO_W3) { const int t = u - UO_W1, e = t >> 7, r = t & 127; tr_unit(C.in(I_W1) + (size_t)e * 2048 * FF, FF, C.in(I_N2G), WSP(bf16, WS_W13) + (size_t)e * 2048 * 2048, 2048, 2, 0, r >> 5, (r & 31) * 64, lane, scr, sub_lo, sub_hi); return; }
    if (u < UO_W2) { const int t = u - UO_W3, e = t >> 7, r = t & 127; tr_unit(C.in(I_W3) + (size_t)e * 2048 * FF, FF, C.in(I_N2G), WSP(bf16, WS_W13) + (size_t)e * 2048 * 2048, 2048, 2, 4, r >> 5, (r & 31) * 64, lane, scr, sub_lo, sub_hi); return; }
    { const int t = u - UO_W2, e = t >> 7, r = t & 127; tr_unit(C.in(I_W2) + (size_t)e * FF * 2048, 2048, nullptr, WSP(bf16, WS_W2) + (size_t)e * 2048 * FF, FF, 0, 0, r >> 4, (r & 15) * 64, lane, scr, sub_lo, sub_hi); }
}
constexpr int BG_UNITS = U_TOTAL - UO_W1;
constexpr int BGL_OFF = LDSCTL_OFF + 1024;
__device__ __forceinline__ void bg_reset(const Ctx& C) { LAS int* st = (LAS int*)(C.lds + BGL_OFF); if (C.tid < 8) { st[2 * C.tid] = -1; st[2 * C.tid + 1] = 8; } }
__device__ __forceinline__ bool bg_step(const Ctx& C) {
    LAS int* st = (LAS int*)(C.lds + BGL_OFF) + 2 * C.wave; LAS float* scr = (LAS float*)(C.lds + C.wave * 8192);
    int u = st[0], sub = st[1];
    if (sub >= 8) {
        if (u == -2) return false;
        int nu = 0; if (C.ln() == 0) nu = (int)__hip_atomic_fetch_add(C.ctl() + CW_BGQ, 1u, __ATOMIC_RELAXED, __HIP_MEMORY_SCOPE_AGENT);
        nu = __builtin_amdgcn_readfirstlane(nu);
        if (nu >= BG_UNITS) { if (C.ln() == 0) { st[0] = -2; st[1] = 8; } return false; }
        u = nu; sub = 0;
    }
    tr_dispatch(C, UO_W1 + u, C.ln(), scr, sub, sub + 1);
    if (C.ln() == 0) { st[0] = u; st[1] = sub + 1; }
    return true;
}
__device__ __forceinline__ void p0_prologue(Ctx& C) {
    const int gw = C.gw, ngw = C.ngw, lane = C.ln();
    {
        LAS int* qc = (LAS int*)(C.lds + 8 * 8192); LAS float* scr = (LAS float*)(C.lds + C.wave * 8192);
        if (C.tid == 0) qc[0] = 0;
        __syncthreads();
        const int G = gridDim.x, ub = (int)(((long)UO_W1 * blockIdx.x) / G), ue = (int)(((long)UO_W1 * (blockIdx.x + 1)) / G);
        for (;;) {
            int u = 0; if (lane == 0) u = __hip_atomic_fetch_add(qc, 1, __ATOMIC_RELAXED, __HIP_MEMORY_SCOPE_WORKGROUP);
            u = __builtin_amdgcn_readfirstlane(u) + ub;
            if (u >= ue) break;
            tr_dispatch(C, u, lane, scr);
        }
    }
    for (int i = gw * 64 + lane; i < (NIN - C_END) * 2048 / 8; i += ngw * 64) { const u32x4 z = {0u, 0u, 0u, 0u}; ((u32x4*)(WSP(bf16, WS_WIN) + (size_t)C_END * 2048))[i] = z; }
    for (int m = gw; m < MR; m += ngw) {
        if (m < M) rms_row_to_bf16(C.in(I_X) + (size_t)m * DM, C.in(I_N1G), WSP(bf16, WS_HN) + (size_t)m * DM, lane);
        else if (m < M + NMETA) rms_row_to_bf16(C.in(I_META) + (size_t)(m - M) * DM, C.in(I_N1G), WSP(bf16, WS_HN) + (size_t)m * DM, lane);
        else { u32x4* o = (u32x4*)(WSP(bf16, WS_HN) + (size_t)m * DM) + lane; const u32x4 z = {0u, 0u, 0u, 0u};
#pragma unroll
            for (int j = 0; j < 4; ++j) o[64 * j] = z; }
    }
    for (int i = gw * 64 + lane; i < (SEQ + NMETA) * 32; i += ngw * 64) {
        const int pos = i >> 5, j = i & 31;
        double inv = 1.0; for (int q = 0; q < j; ++q) inv *= 0.7498942093324559;
        const double rev = (double)pos * inv * 0.15915494309189535;
        const double t = (rev - floor(rev + 0.5)) * 6.283185307179586, t2 = t * t;
        double ps = 1.0, pc = 1.0;
#pragma unroll
        for (int k = 13; k >= 1; --k) { ps = 1.0 - ps * t2 * (1.0 / (double)((2 * k) * (2 * k + 1))); pc = 1.0 - pc * t2 * (1.0 / (double)((2 * k - 1) * (2 * k))); }
        f32x2 cs; cs.x = (float)pc; cs.y = (float)(t * ps); WSP(f32x2, WS_ROPE)[i] = cs;
    }
    for (int i = gw * 64 + lane; i < 48 * DM; i += ngw * 64) {
        const int j = i >> 11, k = i & 2047;
        float w = 0.f;
        if (j < 4) w = C.in(I_WRG)[k * 4 + j] * C.in(I_N2G)[k]; else if (j < 36) w = C.in(I_WRE)[k * 32 + (j - 4)] * C.in(I_N2G)[k];
        WSP(float, WS_WR)[i] = w;
    }
}

__device__ __forceinline__ void xcd_barrier_bg(const XcdBarrier& b, const Ctx& C) {
    asm volatile("s_waitcnt vmcnt(0)" ::: "memory");
    __syncthreads();
    volatile LAS int* flg = (volatile LAS int*)(C.lds + BGL_OFF + 64);
    if (threadIdx.x == 0) {
        unsigned* bar = b.bar;
        __builtin_amdgcn_s_waitcnt(0);
        unsigned nloc = b.st[0], nx = b.st[1];
        if (nloc == 0u) { xcd_barrier_complete(bar, b.x, nloc, nx); b.st[0] = nloc; b.st[1] = nx; }
        const unsigned old = xb_add(&bar[XB_XSUB(b.x)], 1u);
        const unsigned gen = old / nloc;
        if (old + 1u == (gen + 1u) * nloc) {
            __builtin_amdgcn_fence(__ATOMIC_RELEASE, "agent");
            asm volatile("s_waitcnt vmcnt(0)" ::: "memory");
            const unsigned og = xb_add(&bar[XB_TOP], 1u);
            const unsigned tg = og / nx;
            if (og + 1u == (tg + 1u) * nx) xb_add(&bar[XB_TOPGEN], 1u);
            else XB_SPIN(xb_ld(&bar[XB_TOPGEN]) == tg, bar);
            __builtin_amdgcn_fence(__ATOMIC_ACQUIRE, "agent");
            xb_add(&bar[XB_XGEN(b.x)], 1u);
            asm volatile("s_waitcnt vmcnt(0)" ::: "memory");
            flg[0] = 0;
        } else { flg[0] = 1; flg[1] = 0; flg[2] = (int)gen; }
    }
    __syncthreads();
    if (flg[0] == 1) {
        unsigned spins = 0; const unsigned gen = (unsigned)flg[2];
        for (;;) {
            if (C.wave == 0 && C.ln() == 0) { if (xb_ld(&b.bar[XB_XGEN(b.x)]) != gen || xb_ld(&b.bar[XB_TMO]) != 0u) flg[1] = 1; else if (++spins > XB_SPIN_CAP) { atomicAdd(&b.bar[XB_TMO], 1u); flg[1] = 1; } }
            if (flg[1] != 0) break;
            if (!bg_step(C)) __builtin_amdgcn_s_sleep(8);
        }
        __syncthreads();
        if (threadIdx.x == 0) { __builtin_amdgcn_fence(__ATOMIC_ACQUIRE, "agent"); asm volatile("s_waitcnt vmcnt(0)" ::: "memory"); }
    }
    __syncthreads();
}

__device__ __forceinline__ void st8_bf16(bf16* p, const float (&v)[8]) { u32x4 w; w.x = cvt_pk_bf16(v[0], v[1]); w.y = cvt_pk_bf16(v[2], v[3]); w.z = cvt_pk_bf16(v[4], v[5]); w.w = cvt_pk_bf16(v[6], v[7]); *(u32x4*)p = w; }
__device__ __forceinline__ float sigmoidf_(float x) { return __builtin_amdgcn_rcpf(1.f + __builtin_amdgcn_exp2f(-LOG2E * x)); }
struct EpiIn {
    bf16 *QCAT, *SBK, *SBV, *QR, *CKV, *GATE, *KR; const float* b_gate; const f32x2* rope; float* SSQP;
    static constexpr bool HAS_MID = false;
    struct ColPre { f32x4 b0, b1; }; struct RowPre { f32x4 t0, t1; };
    __device__ __forceinline__ int kind(int ocol) const { return ocol < C_SBK ? 0 : ocol < C_SBV ? 1 : ocol < C_QN ? 2 : ocol < C_QR ? 3 : ocol < C_CKV ? 4 : ocol < C_GATE ? 5 : ocol < C_KR ? 6 : 7; }
    __device__ __forceinline__ void col_pre(int kind, int col, ColPre& c) const { if (kind == 6) { c.b0 = *(const f32x4*)(b_gate + (col - C_GATE)); c.b1 = *(const f32x4*)(b_gate + (col - C_GATE) + 4); } }
    __device__ __forceinline__ void row_pre(int kind, int row, int col, RowPre& r) const {
        if (kind == 4 || kind == 7) { const int pos = row < M ? NMETA + (row & (SEQ - 1)) : (row - M); const int j0 = kind == 4 ? (((col - C_QR) & 63) >> 1) : ((col - C_KR) >> 1);
            const f32x4* t = (const f32x4*)(rope + (size_t)pos * 32 + (j0 & 31)); r.t0 = t[0]; r.t1 = t[1]; }
    }
    __device__ __forceinline__ void mid8(int, int, int, float (&)[8], const RowPre&) const {}
    __device__ __forceinline__ void rope8(float (&v)[8], const RowPre& r, float sc) const {
        const float c[4] = {r.t0.x, r.t0.z, r.t1.x, r.t1.z}, sn[4] = {r.t0.y, r.t0.w, r.t1.y, r.t1.w};
#pragma unroll
        for (int q = 0; q < 4; ++q) { const float x1 = v[2 * q], x2 = v[2 * q + 1]; v[2 * q] = (x1 * c[q] - x2 * sn[q]) * sc; v[2 * q + 1] = (x1 * sn[q] + x2 * c[q]) * sc; }
    }
    __device__ __forceinline__ void store8(int kind, int row, int col, float (&v)[8], const ColPre& c, const RowPre& r) const {
        if (kind == 0) {
#pragma unroll
            for (int i = 0; i < 8; ++i) v[i] *= SB_QS;
            st8_bf16(QCAT + (size_t)row * 3072 + col, v);
        } else if (kind == 1) st8_bf16(SBK + (size_t)row * 1024 + (col - C_SBK), v);
        else if (kind == 2) st8_bf16(SBV + (size_t)row * 1024 + (col - C_SBV), v);
        else if (kind == 3) {
#pragma unroll
            for (int i = 0; i < 8; ++i) v[i] *= MLA_QS;
            st8_bf16(QCAT + (size_t)row * 3072 + 1024 + (col - C_QN), v);
        } else if (kind == 4) { rope8(v, r, MLA_QS); st8_bf16(QR + (size_t)row * 1024 + (col - C_QR), v); }
        else if (kind == 5) {
            float ss = 0.f;
#pragma unroll
            for (int i = 0; i < 8; ++i) ss += v[i] * v[i];
            ss += __shfl_xor(ss, 16); ss += __shfl_xor(ss, 32);
            const int cc = col - C_CKV;
            if ((threadIdx.x & 48) == 0) SSQP[(size_t)row * 16 + ((cc >> 8) << 3) + (((cc >> 5) & 3) << 1) + ((cc >> 7) & 1)] = ss;
            st8_bf16(CKV + (size_t)row * 512 + cc, v);
        }
        else if (kind == 6) {
            v[0] = sigmoidf_(v[0] + c.b0.x); v[1] = sigmoidf_(v[1] + c.b0.y); v[2] = sigmoidf_(v[2] + c.b0.z); v[3] = sigmoidf_(v[3] + c.b0.w);
            v[4] = sigmoidf_(v[4] + c.b1.x); v[5] = sigmoidf_(v[5] + c.b1.y); v[6] = sigmoidf_(v[6] + c.b1.z); v[7] = sigmoidf_(v[7] + c.b1.w);
            st8_bf16(GATE + (size_t)row * 4096 + (col - C_GATE), v);
        } else if (col < C_END) { rope8(v, r, 1.f); st8_bf16(KR + (size_t)row * 64 + (col - C_KR), v); }
    }
};
__device__ __forceinline__ void kv_meta_unit(const Ctx& C, int mu) {
    const int lane = C.ln(), r = lane & 15, q = lane >> 4;
    const bf16* A = WSP(bf16, WS_CKV) + (size_t)(M + r) * 512 + q * 8;
    const bf16* B = WSP(bf16, WS_WKV) + (size_t)(16 * mu + r) * 512 + q * 8;
    f32x4 acc = {0.f, 0.f, 0.f, 0.f};
#pragma unroll
    for (int s = 0; s < 16; ++s) acc = __builtin_amdgcn_mfma_f32_16x16x32_bf16(*(const bf16x8*)(A + 32 * s), *(const bf16x8*)(B + 32 * s), acc, 0, 0, 0);
    const int col = 16 * mu + r;
    bf16* dst = col < 2048 ? WSP(bf16, WS_KN) + col : WSP(bf16, WS_VV) + (col - 2048);
#pragma unroll
    for (int i = 0; i < 4; ++i) {
        const int row = M + 4 * q + i; const f32x4* p = (const f32x4*)(WSP(float, WS_SSQP) + (size_t)row * 16);
        const f32x4 qq = (p[0] + p[1]) + (p[2] + p[3]); const float rstd = 1.f / sqrtf(((qq.x + qq.y) + (qq.z + qq.w)) * (1.f / 512.f) + RMS_EPS);
        ((unsigned short*)dst)[(size_t)row * 2048] = (unsigned short)(cvt_pk_bf16(acc[i] * rstd, 0.f) & 0xffffu);
    }
    if (lane < 48) { bf16* z = (16 * mu < 2048 ? WSP(bf16, WS_KN) + 16 * mu : WSP(bf16, WS_VV) + (16 * mu - 2048)) + (size_t)(M + 16 + lane) * 2048;
        const u32x4 zz = {0u, 0u, 0u, 0u}; ((u32x4*)z)[0] = zz; ((u32x4*)z)[1] = zz; }
}
struct EpiKV {
    bf16 *KN, *VV; const float* SSQP; LAS float* rl;
    static constexpr bool HAS_MID = false; static constexpr bool HAS_UNIT_PRE = true;
    struct ColPre {}; struct RowPre { float rstd; };
    __device__ __forceinline__ int kind(int ocol) const { return ocol < 2048 ? 0 : 1; }
    __device__ __forceinline__ void col_pre(int, int, ColPre&) const {}
    __device__ __forceinline__ void row_pre(int, int trow, int, RowPre& r) const { r.rstd = rl[trow]; }
    __device__ __forceinline__ void mid8(int, int, int, float (&)[8], const RowPre&) const {}
    __device__ __forceinline__ void store8(int kind, int row, int col, float (&v)[8], const ColPre&, const RowPre& r) const {
        const float rstd = r.rstd;
#pragma unroll
        for (int i = 0; i < 8; ++i) v[i] *= rstd;
        if (kind == 0) st8_bf16(KN + (size_t)row * 2048 + col, v); else st8_bf16(VV + (size_t)row * 2048 + (col - 2048), v);
    }
};
struct EpiProj {
    const bf16* GATE; bf16* Y;
    static constexpr bool HAS_MID = true;
    struct ColPre {}; struct RowPre { u32x4 a, b; };
    __device__ __forceinline__ int kind(int) const { return 0; }
    __device__ __forceinline__ void col_pre(int, int, ColPre&) const {}
    __device__ __forceinline__ void row_pre(int kind, int row, int col, RowPre& r) const {
        r.b = *(const u32x4*)(GATE + (size_t)row * 4096 + 2048 + col); if (kind == 1) r.a = *(const u32x4*)(GATE + (size_t)row * 4096 + col);
    }
    __device__ __forceinline__ void mid8(int, int, int, float (&v)[8], const RowPre& r) const {
        const unsigned aw[4] = {r.a.x, r.a.y, r.a.z, r.a.w}, bw[4] = {r.b.x, r.b.y, r.b.z, r.b.w};
#pragma unroll
        for (int q = 0; q < 4; ++q) { v[2 * q] *= bflo(aw[q]) * __builtin_amdgcn_rcpf(fmaxf(bflo(bw[q]), 1e-30f)); v[2 * q + 1] *= bfhi(aw[q]) * __builtin_amdgcn_rcpf(fmaxf(bfhi(bw[q]), 1e-30f)); }
    }
    __device__ __forceinline__ void store8(int, int row, int col, float (&v)[8], const ColPre&, const RowPre& r) const {
        const unsigned bw[4] = {r.b.x, r.b.y, r.b.z, r.b.w};
#pragma unroll
        for (int q = 0; q < 4; ++q) { v[2 * q] *= fmaxf(bflo(bw[q]), 1e-30f); v[2 * q + 1] *= fmaxf(bfhi(bw[q]), 1e-30f); }
        st8_bf16(Y + (size_t)row * 2048 + col, v);
    }
};
struct EpiOut {
    const float* x; float* H1; bf16* H1B;
    static constexpr bool HAS_MID = false;
    struct ColPre {}; struct RowPre { f32x4 x0, x1; };
    __device__ __forceinline__ int kind(int) const { return 0; }
    __device__ __forceinline__ void col_pre(int, int, ColPre&) const {}
    __device__ __forceinline__ void row_pre(int, int row, int col, RowPre& r) const { r.x0 = *(const f32x4*)(x + (size_t)row * DM + col); r.x1 = *(const f32x4*)(x + (size_t)row * DM + col + 4); }
    __device__ __forceinline__ void mid8(int, int, int, float (&)[8], const RowPre&) const {}
    __device__ __forceinline__ void store8(int, int row, int col, float (&v)[8], const ColPre&, const RowPre& r) const {
        f32x4 o0 = {v[0] + r.x0.x, v[1] + r.x0.y, v[2] + r.x0.z, v[3] + r.x0.w}, o1 = {v[4] + r.x1.x, v[5] + r.x1.y, v[6] + r.x1.z, v[7] + r.x1.w};
        *(f32x4*)(H1 + (size_t)row * DM + col) = o0; *(f32x4*)(H1 + (size_t)row * DM + col + 4) = o1;
        float w8[8] = {o0.x, o0.y, o0.z, o0.w, o1.x, o1.y, o1.z, o1.w}; st8_bf16(H1B + (size_t)row * DM + col, w8);
    }
};
struct EpiUp {
    bf16* HID; const float* RSS; LAS float* rl;
    static constexpr bool HAS_MID = false;
    struct ColPre {}; struct RowPre { float rs; };
    __device__ __forceinline__ int kind(int) const { return 0; }
    __device__ __forceinline__ void col_pre(int, int, ColPre&) const {}
    __device__ __forceinline__ void row_pre(int, int trow, int, RowPre& r) const { r.rs = rl[trow]; }
    __device__ __forceinline__ void mid8(int, int, int, float (&)[8], const RowPre&) const {}
    __device__ __forceinline__ void store8(int, int row, int col, float (&v)[8], const ColPre&, const RowPre& r) const {
        float h[4];
#pragma unroll
        for (int i = 0; i < 4; ++i) { const float a1 = v[i] * r.rs, a3 = v[4 + i] * r.rs; h[i] = a1 * sigmoidf_(a1) * a3; }
        u32x2 w; w.x = cvt_pk_bf16(h[0], h[1]); w.y = cvt_pk_bf16(h[2], h[3]);
        *(u32x2*)(HID + (size_t)row * FF + (col >> 1)) = w;
    }
};
struct EpiDown {
    bf16* YS;
    static constexpr bool HAS_MID = false;
    struct ColPre {}; struct RowPre {};
    __device__ __forceinline__ int kind(int) const { return 0; }
    __device__ __forceinline__ void col_pre(int, int, ColPre&) const {}
    __device__ __forceinline__ void row_pre(int, int, int, RowPre&) const {}
    __device__ __forceinline__ void mid8(int, int, int, float (&)[8], const RowPre&) const {}
    __device__ __forceinline__ void store8(int, int row, int col, float (&v)[8], const ColPre&, const RowPre&) const { st8_bf16(YS + (size_t)row * 2048 + col, v); }
};
__device__ __forceinline__ int perm32(int rho) { const int n = rho >> 4, i = rho & 15; return 8 * (i >> 2) + 4 * n + (i & 3); }

namespace pg8 {
constexpr int BM = 256, BK = 64, HALF = 128, HTB = HALF * BK * 2, STAGE_BYTES = 8 * HTB, NXCD = 8, WGM = 8;
__device__ __forceinline__ int lds_byte(int r, int c) { const int st = (r >> 4) * 2 + (c >> 5), rr = r & 15, cc = c & 31, ob = rr * 64 + cc * 2; return st * 1024 + (ob ^ (((ob >> 9) & 1) << 5)); }
__device__ __forceinline__ void stage_rc(int b, int& R, int& C) { const int st = b / 1024, sb = b % 1024, swz = sb ^ (((sb >> 9) & 1) << 5); R = (st >> 1) * 16 + swz / 64; C = (st & 1) * 32 + (swz % 64) / 2; }
struct Unit { int arow, brow, orow, ocol, idx; };
struct Gemm { const bf16* A; const bf16* Bt; int lda, ldb, K, mid_t; };
__device__ __forceinline__ bool tile_of(int i, int G, int c, int nM, int nN, int& pm, int& pn) {
    const int nwg = nM * nN; const long L = (long)i * G + c; if (L >= nwg) return false;
    int wgid = (int)L; { const int q = nwg / NXCD, r = nwg % NXCD, xcd = wgid % NXCD, off = wgid / NXCD; wgid = (xcd < r ? xcd * (q + 1) : r * (q + 1) + (xcd - r) * q) + off; }
    const int nig = WGM * nN, gid = wgid / nig, fm = gid * WGM, gsz = (nM - fm) < WGM ? (nM - fm) : WGM;
    pm = fm + ((wgid % nig) % gsz); pn = (wgid % nig) / gsz; return true;
}
struct DenseOrder { static constexpr bool GATHER = false; int nM, nN, G, c;
    __device__ __forceinline__ bool next(int i, Unit& u) const { int pm, pn; if (!tile_of(i, G, c, nM, nN, pm, pn)) return false; u.arow = pm * BM; u.brow = pn * BM; u.orow = pm * BM; u.ocol = pn * BM; u.idx = i; return true; } };
struct GroupOrder { static constexpr bool GATHER = false; int nT, G, c; const LAS int* tt; int maxi;
    __device__ __forceinline__ bool next(int i, Unit& u) const {
        const int nwg = nT * 8; const long L = (long)i * G + c; if (i >= maxi || L >= nwg) return false;
        int wgid = (int)L; { const int q = nwg / NXCD, r = nwg % NXCD, xcd = wgid % NXCD, off = wgid / NXCD; wgid = (xcd < r ? xcd * (q + 1) : r * (q + 1) + (xcd - r) * q) + off; }
        const int t = wgid >> 3, cn = wgid & 7; const int e = __builtin_amdgcn_readfirstlane(tt[t]);
        u.arow = t * BM; u.brow = e * 2048 + cn * BM; u.orow = t * BM; u.ocol = cn * BM; u.idx = i; return true; } };
struct HalfOrder { static constexpr bool GATHER = false; int nT, G, c, R; const LAS int* tt;
    __device__ __forceinline__ bool next(int i, Unit& u) const {
        const int nwg = nT * 8; const long L = (long)R * G + (c >> 1); if (i > 0 || L >= nwg) return false;
        int wgid = (int)L; { const int q = nwg / NXCD, r = nwg % NXCD, xcd = wgid % NXCD, off = wgid / NXCD; wgid = (xcd < r ? xcd * (q + 1) : r * (q + 1) + (xcd - r) * q) + off; }
        const int t = wgid >> 3, cn = wgid & 7; const int e = __builtin_amdgcn_readfirstlane(tt[t]);
        u.arow = t * BM; u.brow = e * 2048 + cn * BM + (c & 1) * HALF; u.orow = t * BM; u.ocol = cn * BM + (c & 1) * HALF; u.idx = 8; return true; } };
template <class O> struct GatherOf { static constexpr bool GATHER = true; O o; const LAS int* stok;
    __device__ __forceinline__ bool next(int i, Unit& u) const { return o.next(i, u); } };
struct GatherOrder { static constexpr bool GATHER = true; GroupOrder o; const LAS int* stok;
    __device__ __forceinline__ bool next(int i, Unit& u) const { return o.next(i, u); } };
#define PIPE_EPI_OF(F) (__is_same(F, EpiProj) || __is_same(F, EpiOut))
template <class F> struct EpiW {
    F f; static constexpr bool HAS_MID = F::HAS_MID;
    template <bool HN, int K> __device__ __forceinline__ void body(f32x4 (&acc)[2][2][4][2], const Unit& u, int wr, int wc, int fr, int fq) const {
        constexpr int NBJ = HN ? 1 : 2;
        constexpr bool TAB = __is_same(F, EpiKV) || __is_same(F, EpiUp);
        const int rbase = TAB ? u.idx * 256 - u.orow : 0;
        const int row0 = u.orow + wr * 64 + fr, col0 = u.ocol + wc * 32 + 8 * fq;
        constexpr int kind = K;
        typename F::ColPre cp[2];
#pragma unroll
        for (int bj = 0; bj < NBJ; ++bj) f.col_pre(kind, col0 + bj * HALF, cp[bj]);
        constexpr bool PIPE = PIPE_EPI_OF(F);
        typename F::RowPre rp[2][2][2];
        if constexpr (PIPE) {
#pragma unroll
        for (int mm = 0; mm < 2; ++mm)
#pragma unroll
            for (int bj = 0; bj < NBJ; ++bj) f.row_pre(kind, rbase + row0 + mm * 16, col0 + bj * HALF, rp[0][mm][bj]); }
#pragma unroll
        for (int b = 0; b < 4; ++b) {
            const int ai = b >> 1, mp = (b & 1) * 2;
            if constexpr (!PIPE) {
#pragma unroll
                for (int mm = 0; mm < 2; ++mm)
#pragma unroll
                    for (int bj = 0; bj < NBJ; ++bj) f.row_pre(kind, rbase + row0 + ai * HALF + (mp + mm) * 16, col0 + bj * HALF, rp[b & 1][mm][bj]); }
            if (PIPE && b + 1 < 4) { const int ai2 = (b + 1) >> 1, mp2 = ((b + 1) & 1) * 2;
#pragma unroll
                for (int mm = 0; mm < 2; ++mm)
#pragma unroll
                    for (int bj = 0; bj < NBJ; ++bj) f.row_pre(kind, rbase + row0 + ai2 * HALF + (mp2 + mm) * 16, col0 + bj * HALF, rp[(b + 1) & 1][mm][bj]); }
#pragma unroll
            for (int mm = 0; mm < 2; ++mm)
#pragma unroll
                for (int bj = 0; bj < NBJ; ++bj) { const int m = mp + mm; const f32x4 a = acc[ai][bj][m][0], bb = acc[ai][bj][m][1]; float v[8] = {a[0], a[1], a[2], a[3], bb[0], bb[1], bb[2], bb[3]};
                    f.store8(kind, row0 + ai * HALF + m * 16, col0 + bj * HALF, v, cp[bj], rp[b & 1][mm][bj]);
                    acc[ai][bj][m][0] = (f32x4){0.f, 0.f, 0.f, 0.f}; acc[ai][bj][m][1] = (f32x4){0.f, 0.f, 0.f, 0.f}; }
        }
    }
    template <bool HN = false> __device__ __forceinline__ void run(f32x4 (&acc)[2][2][4][2], const Unit& u, int wr, int wc, int fr, int fq) const {
        if constexpr (__is_same(F, EpiIn)) {
            const int kind = __builtin_amdgcn_readfirstlane(f.kind(u.ocol));
            switch (kind) { case 0: body<HN, 0>(acc, u, wr, wc, fr, fq); break; case 1: body<HN, 1>(acc, u, wr, wc, fr, fq); break; case 2: body<HN, 2>(acc, u, wr, wc, fr, fq); break;
                            case 3: body<HN, 3>(acc, u, wr, wc, fr, fq); break; case 4: body<HN, 4>(acc, u, wr, wc, fr, fq); break; case 5: body<HN, 5>(acc, u, wr, wc, fr, fq); break;
                            case 6: body<HN, 6>(acc, u, wr, wc, fr, fq); break; default: body<HN, 7>(acc, u, wr, wc, fr, fq); break; }
        } else if constexpr (__is_same(F, EpiKV)) {
            if (u.ocol < 2048) body<HN, 0>(acc, u, wr, wc, fr, fq); else body<HN, 1>(acc, u, wr, wc, fr, fq);
        } else body<HN, 0>(acc, u, wr, wc, fr, fq);
    }
    __device__ __forceinline__ void mid(f32x4 (&acc)[2][2][4][2], const Unit& u, int wr, int wc, int fr, int fq) const {
        int row0 = u.orow + wr * 64 + fr, col0 = u.ocol + wc * 32 + 8 * fq;
        asm volatile("" : "+v"(row0), "+v"(col0));
        typename F::RowPre rp[2][2][2];
#pragma unroll
        for (int mm = 0; mm < 2; ++mm)
#pragma unroll
            for (int bj = 0; bj < 2; ++bj) f.row_pre(1, row0 + mm * 16, col0 + bj * HALF, rp[0][mm][bj]);
#pragma unroll
        for (int b = 0; b < 4; ++b) {
            const int ai = b >> 1, mp = (b & 1) * 2;
            if (b + 1 < 4) { const int ai2 = (b + 1) >> 1, mp2 = ((b + 1) & 1) * 2;
#pragma unroll
                for (int mm = 0; mm < 2; ++mm)
#pragma unroll
                    for (int bj = 0; bj < 2; ++bj) f.row_pre(1, row0 + ai2 * HALF + (mp2 + mm) * 16, col0 + bj * HALF, rp[(b + 1) & 1][mm][bj]); }
#pragma unroll
            for (int mm = 0; mm < 2; ++mm)
#pragma unroll
                for (int bj = 0; bj < 2; ++bj) { const int m = mp + mm; const f32x4 a = acc[ai][bj][m][0], bb = acc[ai][bj][m][1]; float v[8] = {a[0], a[1], a[2], a[3], bb[0], bb[1], bb[2], bb[3]};
                    f.mid8(1, row0 + ai * HALF + m * 16, col0 + bj * HALF, v, rp[b & 1][mm][bj]);
                    acc[ai][bj][m][0] = (f32x4){v[0], v[1], v[2], v[3]}; acc[ai][bj][m][1] = (f32x4){v[4], v[5], v[6], v[7]}; }
            asm volatile("" : "+v"(acc[ai][0][mp][0]), "+v"(acc[ai][0][mp][1]), "+v"(acc[ai][1][mp][0]), "+v"(acc[ai][1][mp][1]), "+v"(acc[ai][0][mp + 1][0]), "+v"(acc[ai][0][mp + 1][1]), "+v"(acc[ai][1][mp + 1][0]), "+v"(acc[ai][1][mp + 1][1]) :: "memory");
        }
    }
};
template <bool HN = false, class Epi, class Sched>
__device__ __forceinline__ void gemm_phase(LAS unsigned char* lds, const Gemm g, const Sched& S, const Epi& E) {
    const int tid = threadIdx.x, wid = __builtin_amdgcn_readfirstlane(tid >> 6), lane = tid & 63, wr = wid >> 2, wc = wid & 3, fr = lane & 15, fq = lane >> 4;
    const int nt = g.K / BK;
    unsigned voffA[2], voffB[2];
#pragma unroll
    for (int i = 0; i < 2; ++i) { int R, C; stage_rc(tid * 16 + i * 8192, R, C); const int Rb = (R & ~31) + perm32(R & 31);
        voffA[i] = (unsigned)(R * g.lda + C) * 2u; voffB[i] = (unsigned)(Rb * g.ldb + C) * 2u; }
    int gR[2], gC[2];
#pragma unroll
    for (int i = 0; i < 2; ++i) stage_rc(tid * 16 + i * 8192, gR[i], gC[i]);
    unsigned vG[2][2] = {{0u, 0u}, {0u, 0u}}, vGn[2][2] = {{0u, 0u}, {0u, 0u}};
#define PG8_GLOOK(dst, un) do { _Pragma("unroll") for (int h_ = 0; h_ < 2; ++h_) _Pragma("unroll") for (int i_ = 0; i_ < 2; ++i_) \
        dst[h_][i_] = (unsigned)(S.stok[(un).idx * 256 + h_ * HALF + gR[i_]] * g.lda + gC[i_]) * 2u; } while (0)
    const size_t kstep = (size_t)(BK * 2);
    const size_t hstepA = (size_t)HALF * g.lda * 2, hstepB = (size_t)HALF * g.ldb * 2;
    const unsigned ldsw = (unsigned)wid * 1024u;
    const int aoff = lds_byte(wr * 64 + fr, fq * 8), boff = lds_byte(wc * 32 + fr, fq * 8);
#define PG8_SA(b, h) (((b) * 2 + (h)) * HTB)
#define PG8_SB(b, h) ((4 + (b) * 2 + (h)) * HTB)
#define PG8_STAGE(bufoff, gbase, voff) do { _Pragma("unroll") for (int _i = 0; _i < 2; ++_i) \
        __builtin_amdgcn_global_load_lds((const unsigned*)((const char*)(gbase) + (voff)[_i]), (LAS unsigned*)(lds + (bufoff) + ldsw + _i * 8192), 16, 0, 0); } while (0)
#define PG8_LDA(dst, b, h) do { _Pragma("unroll") for (int m = 0; m < 4; ++m) _Pragma("unroll") for (int k = 0; k < 2; ++k) dst[m][k] = *(const LAS bf16x8*)(lds + PG8_SA(b, h) + aoff + m * 2048 + k * 1024); } while (0)
#define PG8_LDB(dst, b, h) do { _Pragma("unroll") for (int n = 0; n < 2; ++n) _Pragma("unroll") for (int k = 0; k < 2; ++k) dst[n][k] = *(const LAS bf16x8*)(lds + PG8_SB(b, h) + boff + n * 2048 + k * 1024); } while (0)
#define PG8_MMA(ai, bj, At, Bt) do { __builtin_amdgcn_s_setprio(1); _Pragma("unroll") for (int m = 0; m < 4; ++m) _Pragma("unroll") for (int n = 0; n < 2; ++n) _Pragma("unroll") for (int k = 0; k < 2; ++k) \
        acc[ai][bj][m][n] = __builtin_amdgcn_mfma_f32_16x16x32_bf16(Bt[n][k], At[m][k], acc[ai][bj][m][n], 0, 0, 0); __builtin_amdgcn_s_setprio(0); } while (0)
#define PG8_WAIT_V(n) asm volatile("s_waitcnt vmcnt(" #n ")" ::: "memory")
#define PG8_WAIT_VK() do { if constexpr (HN) PG8_WAIT_V(6); else PG8_WAIT_V(8); } while (0)
#define PG8_WAIT_L(n) asm volatile("s_waitcnt lgkmcnt(" #n ")" ::: "memory")
#define PG8_BAR __builtin_amdgcn_s_barrier()
#define PG8_SCHED __builtin_amdgcn_sched_barrier(0)
    Unit cur, nxt; int ui = 0;
    if (!S.next(0, cur)) return;
    f32x4 acc[2][2][4][2];
#pragma unroll
    for (int a = 0; a < 2; ++a)
#pragma unroll
        for (int b = 0; b < 2; ++b)
#pragma unroll
            for (int m = 0; m < 4; ++m)
#pragma unroll
                for (int n = 0; n < 2; ++n) acc[a][b][m][n] = (f32x4){0.f, 0.f, 0.f, 0.f};
    bf16x8 At[4][2], B0[2][2], B1[2][2];
    const char* cA = Sched::GATHER ? (const char*)g.A : (const char*)g.A + (size_t)cur.arow * g.lda * 2; const char* cB = (const char*)g.Bt + (size_t)cur.brow * g.ldb * 2;
    if constexpr (Sched::GATHER) PG8_GLOOK(vG, cur);
#define PG8_STAGE_A(bufoff, kptr, half, nextu) do { if constexpr (Sched::GATHER) { if (nextu) PG8_STAGE(bufoff, kptr, vGn[half]); else PG8_STAGE(bufoff, kptr, vG[half]); } \
        else PG8_STAGE(bufoff, (kptr) + (half) * hstepA, voffA); } while (0)
    PG8_STAGE(PG8_SB(0, 0), cB, voffB); if constexpr (!HN) PG8_STAGE(PG8_SB(0, 1), cB + hstepB, voffB); PG8_STAGE_A(PG8_SA(0, 0), cA, 0, false); PG8_STAGE_A(PG8_SA(0, 1), cA, 1, false);
    if (wr == 1) PG8_BAR;
    PG8_WAIT_V(2); PG8_BAR;
    PG8_STAGE(PG8_SB(1, 0), cB + kstep, voffB); PG8_STAGE_A(PG8_SA(1, 0), cA + kstep, 0, false); if constexpr (!HN) PG8_STAGE(PG8_SB(1, 1), cB + hstepB + kstep, voffB);
    if constexpr (HN) PG8_WAIT_V(4); else PG8_WAIT_V(6); PG8_BAR;
    for (;;) {
        const bool has_next = S.next(ui + 1, nxt);
        const char* nA = Sched::GATHER ? cA : (has_next ? (const char*)g.A + (size_t)nxt.arow * g.lda * 2 : cA); const char* nB = has_next ? (const char*)g.Bt + (size_t)nxt.brow * g.ldb * 2 : cB;
        if constexpr (Sched::GATHER) { if (has_next) PG8_GLOOK(vGn, nxt); else { _Pragma("unroll") for (int h_ = 0; h_ < 2; ++h_) _Pragma("unroll") for (int i_ = 0; i_ < 2; ++i_) vGn[h_][i_] = vG[h_][i_]; } }
        for (int t = 0; t < nt; t += 2) {
            if constexpr (Epi::HAS_MID) { if (t == g.mid_t) { PG8_SCHED; E.mid(acc, cur, wr, wc, fr, fq); PG8_SCHED; } PG8_SCHED; }
            const bool last = (t == nt - 2);
            const char* a1 = cA + (size_t)(t + 1) * kstep;
            const char* a2 = last ? nA : cA + (size_t)(t + 2) * kstep; const char* b2 = last ? nB : cB + (size_t)(t + 2) * kstep;
            const char* a3 = a2 + kstep; const char* b3 = b2 + kstep;
            int sk_ = (t == 0) & (ui > 0); asm volatile("" : "+v"(sk_)); sk_ = __builtin_amdgcn_readfirstlane(sk_);
            PG8_LDB(B0, 0, 0); if constexpr (!HN) PG8_LDB(B1, 0, 1); PG8_SCHED; PG8_LDA(At, 0, 0); PG8_STAGE_A(PG8_SA(1, 1), a1, 1, false);
            if (!sk_) PG8_WAIT_VK(); PG8_WAIT_L(0); PG8_BAR; PG8_MMA(0, 0, At, B0); if constexpr (!HN) PG8_MMA(0, 1, At, B1); PG8_BAR; PG8_SCHED;
            PG8_LDA(At, 0, 1); PG8_STAGE(PG8_SB(0, 0), b2, voffB); if constexpr (!HN) PG8_STAGE(PG8_SB(0, 1), b2 + hstepB, voffB); PG8_STAGE_A(PG8_SA(0, 0), a2, 0, last);
            if (!sk_) PG8_WAIT_VK(); PG8_WAIT_L(0); PG8_BAR; PG8_MMA(1, 0, At, B0); if constexpr (!HN) PG8_MMA(1, 1, At, B1); PG8_BAR; PG8_SCHED;
            PG8_LDB(B0, 1, 0); if constexpr (!HN) PG8_LDB(B1, 1, 1); PG8_SCHED; PG8_LDA(At, 1, 0); PG8_STAGE_A(PG8_SA(0, 1), a2, 1, last);
            PG8_WAIT_VK(); PG8_WAIT_L(0); PG8_BAR; PG8_MMA(0, 0, At, B0); if constexpr (!HN) PG8_MMA(0, 1, At, B1); PG8_BAR; PG8_SCHED;
            PG8_LDA(At, 1, 1); PG8_STAGE(PG8_SB(1, 0), b3, voffB); if constexpr (!HN) PG8_STAGE(PG8_SB(1, 1), b3 + hstepB, voffB); PG8_STAGE_A(PG8_SA(1, 0), a3, 0, last);
            PG8_WAIT_VK(); PG8_WAIT_L(0); PG8_BAR; PG8_MMA(1, 0, At, B0); if constexpr (!HN) PG8_MMA(1, 1, At, B1); PG8_BAR; PG8_SCHED;
        }
        if (wr == 0) PG8_BAR;
        PG8_WAIT_V(0);
        E.template run<HN>(acc, cur, wr, wc, fr, fq);
        if (!has_next) break;
        cur = nxt; cA = nA; cB = nB; ++ui;
        if constexpr (Sched::GATHER) { _Pragma("unroll") for (int h_ = 0; h_ < 2; ++h_) _Pragma("unroll") for (int i_ = 0; i_ < 2; ++i_) vG[h_][i_] = vGn[h_][i_]; }
        if (wr == 1) PG8_BAR;
    }
    PG8_WAIT_V(0);
    PG8_BAR;
#undef PG8_SA
#undef PG8_STAGE_A
#undef PG8_GLOOK
#undef PG8_SB
#undef PG8_STAGE
#undef PG8_LDA
#undef PG8_LDB
#undef PG8_MMA
#undef PG8_WAIT_V
#undef PG8_WAIT_VK
#undef PG8_WAIT_L
#undef PG8_BAR
#undef PG8_SCHED
}
}

#ifndef DBL_ATT
#define DBL_ATT 0
#endif
namespace att {
typedef float f32x16 __attribute__((ext_vector_type(16)));
typedef short s16x4 __attribute__((ext_vector_type(4)));
constexpr int SHM_V = 16384, SHM_K = 16384, SHM_R = 8192;
constexpr int OFF_V = 0, OFF_K = 2 * SHM_V, OFF_R = OFF_K + 2 * SHM_K, OFF_WS = OFF_R + 2 * SHM_R, OFF_FL = OFF_WS + 2048, OFF_QRL = OFF_FL + 64, LDS_ATT = OFF_QRL + 8 * 4096;
#define KSWZ(row, colB) ((row) * 256 + ((colB) ^ (((row) & 7) << 4)))
#define RSWZ(row, colB) ((row) * 128 + ((colB) ^ (((row) & 7) << 4)))
#define SBAR() __builtin_amdgcn_sched_barrier(0)
__device__ __forceinline__ int crow(int r, int hi) { return (r & 3) + 8 * (r >> 2) + 4 * hi; }
__device__ __forceinline__ unsigned cvtpk(float lo, float hi) { return cvt_pk_bf16(lo, hi); }
constexpr float THRL = 11.5f;
__device__ __forceinline__ void partialSM(f32x16& p0, f32x16& p1, float& m_reg, float& mn, float& alpha) {
    float pmax = p0[0];
#pragma unroll
    for (int r = 1; r < 16; ++r) pmax = fmaxf(pmax, p0[r]);
#pragma unroll
    for (int r = 0; r < 16; ++r) pmax = fmaxf(pmax, p1[r]);
    { auto rr = __builtin_amdgcn_permlane32_swap(__float_as_uint(pmax), __float_as_uint(pmax), false, false); pmax = fmaxf(__uint_as_float(rr[0]), __uint_as_float(rr[1])); }
    if (__builtin_expect(__all(pmax - m_reg <= THRL), 1)) { mn = m_reg; alpha = 1.f; }
    else { mn = fmaxf(m_reg, pmax); alpha = __builtin_amdgcn_exp2f(m_reg - mn); m_reg = mn; }
#pragma unroll
    for (int r = 0; r < 16; ++r) p0[r] = p0[r] - mn;
#pragma unroll
    for (int r = 0; r < 16; ++r) p1[r] = p1[r] - mn;
#pragma unroll
    for (int r = 0; r < 16; ++r) p0[r] = __builtin_amdgcn_exp2f(p0[r]);
}
#define PK4(P, BASE, OUT) do { unsigned a0 = cvtpk(P[BASE + 0], P[BASE + 1]), a1 = cvtpk(P[BASE + 2], P[BASE + 3]);   \
    unsigned b0 = cvtpk(P[BASE + 4], P[BASE + 5]), b1 = cvtpk(P[BASE + 6], P[BASE + 7]);                              \
    auto r0 = __builtin_amdgcn_permlane32_swap(a0, b0, false, false); auto r1 = __builtin_amdgcn_permlane32_swap(a1, b1, false, false); \
    u32x4 w = {r0[0], r1[0], r0[1], r1[1]}; OUT = *reinterpret_cast<bf16x8*>(&w); } while (0)
__device__ __forceinline__ void finishSM(f32x16& p0, f32x16& p1, float alpha, float& l_reg, bf16x8& pa0, bf16x8& pa1, bf16x8& pa2, bf16x8& pa3) {
#pragma unroll
    for (int r = 0; r < 16; ++r) p1[r] = __builtin_amdgcn_exp2f(p1[r]);
    float s0 = p0[0], s1 = p0[1], s2 = p0[2], s3 = p0[3];
#pragma unroll
    for (int r = 4; r < 16; r += 4) { s0 += p0[r]; s1 += p0[r + 1]; s2 += p0[r + 2]; s3 += p0[r + 3]; }
#pragma unroll
    for (int r = 0; r < 16; r += 4) { s0 += p1[r]; s1 += p1[r + 1]; s2 += p1[r + 2]; s3 += p1[r + 3]; }
    float ps = (s0 + s1) + (s2 + s3);
    { auto rr = __builtin_amdgcn_permlane32_swap(__float_as_uint(ps), __float_as_uint(ps), false, false); ps = __uint_as_float(rr[0]) + __uint_as_float(rr[1]); }
    l_reg = l_reg * alpha + ps;
    PK4(p0, 0, pa0); PK4(p0, 8, pa1); PK4(p1, 0, pa2); PK4(p1, 8, pa3);
}
template <int NR>
__device__ __forceinline__ void qkt(f32x16& p0, f32x16& p1, const LAS char* Ks, const LAS char* Rs, const bf16x8* qr, const LAS char* qrl, int r32, int hi) {
    p0 = f32x16{}; p1 = f32x16{};
#pragma unroll
    for (int d0 = 0; d0 < 8; ++d0) { const int cb = (d0 * 16 + hi * 8) * 2;
        const bf16x8 b0 = *(const LAS bf16x8*)(Ks + KSWZ(r32, cb));
        const bf16x8 b1 = *(const LAS bf16x8*)(Ks + KSWZ(32 + r32, cb));
        p0 = __builtin_amdgcn_mfma_f32_32x32x16_bf16(b0, qr[d0], p0, 0, 0, 0);
        p1 = __builtin_amdgcn_mfma_f32_32x32x16_bf16(b1, qr[d0], p1, 0, 0, 0); }
#pragma unroll
    for (int d0 = 0; d0 < NR; ++d0) { const int cb = (d0 * 16 + hi * 8) * 2;
        const bf16x8 b0 = *(const LAS bf16x8*)(Rs + RSWZ(r32, cb));
        const bf16x8 b1 = *(const LAS bf16x8*)(Rs + RSWZ(32 + r32, cb));
        const bf16x8 qf = *(const LAS bf16x8*)(qrl + d0 * 1024);
        p0 = __builtin_amdgcn_mfma_f32_32x32x16_bf16(b0, qf, p0, 0, 0, 0);
        p1 = __builtin_amdgcn_mfma_f32_32x32x16_bf16(b1, qf, p1, 0, 0, 0); }
}
__device__ __forceinline__ int v_st(int k, int c) { const int kk = (k & ~0xC) | ((k & 4) << 1) | ((k & 8) >> 1); return ((kk >> 3) * 4 + (c >> 5)) * 512 + ((kk & 7) * 32 + (c & 31)) * 2; }
__device__ __forceinline__ int v_rd_base(int lane) { return ((lane & 3) << 3) | (((lane >> 2) & 3) << 6) | (((lane >> 4) & 1) << 5) | (((lane >> 5) & 1) << 8); }
constexpr int v_rd_off(int d0, int ks, int half) { return d0 * 512 + ks * 4096 + half * 2048; }
template <int OFF> __device__ __forceinline__ s16x4 tr_read(int vb) { s16x4 r; asm volatile("ds_read_b64_tr_b16 %0, %1 offset:%2" : "=&v"(r) : "v"(vb), "i"(OFF) : "memory"); return r; }
template <int D0> __device__ __forceinline__ void pv_one(f32x16& od, int vb, bf16x8 pa0, bf16x8 pa1, bf16x8 pa2, bf16x8 pa3) {
    const s16x4 l0 = tr_read<v_rd_off(D0, 0, 0)>(vb), h0 = tr_read<v_rd_off(D0, 0, 1)>(vb), l1 = tr_read<v_rd_off(D0, 1, 0)>(vb), h1 = tr_read<v_rd_off(D0, 1, 1)>(vb);
    const s16x4 l2 = tr_read<v_rd_off(D0, 2, 0)>(vb), h2 = tr_read<v_rd_off(D0, 2, 1)>(vb), l3 = tr_read<v_rd_off(D0, 3, 0)>(vb), h3 = tr_read<v_rd_off(D0, 3, 1)>(vb);
    asm volatile("s_waitcnt lgkmcnt(0)" ::: "memory"); SBAR();
#define PKV(L, H) (bf16x8){L[0], L[1], L[2], L[3], H[0], H[1], H[2], H[3]}
    od = __builtin_amdgcn_mfma_f32_32x32x16_bf16(pa0, PKV(l0, h0), od, 0, 0, 0);
    od = __builtin_amdgcn_mfma_f32_32x32x16_bf16(pa1, PKV(l1, h1), od, 0, 0, 0);
    od = __builtin_amdgcn_mfma_f32_32x32x16_bf16(pa2, PKV(l2, h2), od, 0, 0, 0);
    od = __builtin_amdgcn_mfma_f32_32x32x16_bf16(pa3, PKV(l3, h3), od, 0, 0, 0);
#undef PKV
}
__device__ __forceinline__ void pv_d0(f32x16* o, int vb, bf16x8 pa0, bf16x8 pa1, bf16x8 pa2, bf16x8 pa3) {
    pv_one<0>(o[0], vb, pa0, pa1, pa2, pa3); pv_one<1>(o[1], vb, pa0, pa1, pa2, pa3); pv_one<2>(o[2], vb, pa0, pa1, pa2, pa3); pv_one<3>(o[3], vb, pa0, pa1, pa2, pa3);
}
__device__ __forceinline__ void store_o(const f32x16* o, const float* rli, bf16* Ow, int ldo, int r32, int hi) {
#pragma unroll
    for (int r = 0; r < 16; ++r) { const int orow = crow(r, hi);
#pragma unroll
        for (int d0 = 0; d0 < 4; ++d0) Ow[(size_t)orow * ldo + d0 * 32 + r32] = (bf16)(cvtpk(o[d0][r] * rli[r], 0.f) & 0xffffu); }
}

#ifdef MLA_EQ
#define QK_PIPE() do { } while (0)
#else
#define QK_PIPE() do { _Pragma("unroll") for (int i_ = 0; i_ < 24; ++i_) { __builtin_amdgcn_sched_group_barrier(0x008, 1, 0); __builtin_amdgcn_sched_group_barrier(0x400, 1, 0); __builtin_amdgcn_sched_group_barrier(0x002, 3, 0); } } while (0)
#endif
__device__ __forceinline__ void mla_unit(const Ctx& C, int b, int h, int m, LAS char* lds, bf16* odummy) {
    const int tid = threadIdx.x, wid = __builtin_amdgcn_readfirstlane(tid >> 6), lane = tid & 63, r32 = lane & 31, hi = lane >> 5;
    LAS char* V_lds = lds + OFF_V; LAS char* K_lds = lds + OFF_K; LAS char* R_lds = lds + OFF_R;
    LAS float* ws = (LAS float*)(lds + OFF_WS) + wid * 64; LAS float* li_l = ws; LAS float* al_l = ws + 32;
    const int rb = b * SEQ, q0 = 256 * m, NT = 4 * m + 5;
    bf16* Qn = WSP(bf16, WS_QCAT) + (size_t)(rb + q0 + wid * 32) * 3072 + 1024 + h * 128;
    const bf16* Qr = WSP(bf16, WS_QR) + (size_t)(rb + q0 + wid * 32) * 1024 + h * 64;
    const bf16* Kh = WSP(bf16, WS_KN) + h * 128; const bf16* Vh = WSP(bf16, WS_VV) + h * 128; const bf16* Rh = WSP(bf16, WS_KR);
    float m_reg = -1e30f, l_reg = 0.f; f32x16 o[4] = {}; bf16x8 qr[8];
    LAS char* qrl = lds + OFF_QRL + wid * 4096 + lane * 16;
#pragma unroll
    for (int d0 = 0; d0 < 8; ++d0) qr[d0] = *(const bf16x8*)(Qn + (size_t)r32 * 3072 + hi * 8 + d0 * 16);
#pragma unroll
    for (int d0 = 0; d0 < 4; ++d0) *(LAS bf16x8*)(qrl + d0 * 1024) = *(const bf16x8*)(Qr + (size_t)r32 * 1024 + hi * 8 + d0 * 16);
    const int sr = tid >> 4, sc = (tid & 15) * 8, vst0 = v_st(sr, sc), vst1 = v_st(32 + sr, sc), rr_ = tid >> 3, rc = (tid & 7) * 8;
    const int vb0 = (int)(unsigned)(uintptr_t)V_lds + v_rd_base(lane);
    bf16x8 vs0, vs1, ks0, ks1, krs;
#define TROW(t) ((t) == 0 ? M : rb + ((t) - 1) * 64)
    const unsigned voffKV = (unsigned)(sr * 2048 + sc) * 2u, voffR = (unsigned)(rr_ * 64 + rc) * 2u;
#define SLOAD(t) do { const int r0_ = __builtin_amdgcn_readfirstlane(TROW(t)); const char* vt_ = (const char*)Vh + (size_t)r0_ * 4096; const char* kt_ = (const char*)Kh + (size_t)r0_ * 4096; const char* rt_ = (const char*)Rh + (size_t)r0_ * 128; \
        vs0 = *(const bf16x8*)(vt_ + voffKV); vs1 = *(const bf16x8*)(vt_ + 32 * 4096 + voffKV); \
        ks0 = *(const bf16x8*)(kt_ + voffKV); ks1 = *(const bf16x8*)(kt_ + 32 * 4096 + voffKV); krs = *(const bf16x8*)(rt_ + voffR); } while (0)
#define SWRITE(bf) do { *(LAS bf16x8*)(V_lds + (bf) * SHM_V + vst0) = vs0; *(LAS bf16x8*)(V_lds + (bf) * SHM_V + vst1) = vs1; \
        *(LAS bf16x8*)(K_lds + (bf) * SHM_K + KSWZ(sr, sc * 2)) = ks0; *(LAS bf16x8*)(K_lds + (bf) * SHM_K + KSWZ(32 + sr, sc * 2)) = ks1; \
        *(LAS bf16x8*)(R_lds + (bf) * SHM_R + RSWZ(rr_, rc * 2)) = krs; } while (0)
#define RESC(a) do { if (__any((a) < 1.f)) { if (hi == 0) al_l[r32] = (a); asm volatile("s_waitcnt lgkmcnt(0)" ::: "memory"); \
        _Pragma("unroll") for (int d = 0; d < 4; ++d) _Pragma("unroll") for (int r = 0; r < 16; ++r) o[d][r] *= al_l[crow(r, hi)]; } } while (0)
#define MASK(P0, P1, t) do { if ((t) == 0) { _Pragma("unroll") for (int r = 8; r < 16; ++r) P0[r] = -1e30f; _Pragma("unroll") for (int r = 0; r < 16; ++r) P1[r] = -1e30f; } \
        else if ((t) - 1 - 4 * m > (wid >> 1)) { _Pragma("unroll") for (int r = 0; r < 16; ++r) { P0[r] = -1e30f; P1[r] = -1e30f; } } } while (0)
    f32x16 pA0, pA1, pB0, pB1; float mnA, mnB, alA, alB; bf16x8 pa0, pa1, pa2, pa3;
    SLOAD(0); asm volatile("s_waitcnt vmcnt(0)" ::: "memory"); SWRITE(0); __syncthreads();
    qkt<4>(pA0, pA1, K_lds, R_lds, qr, qrl, r32, hi); MASK(pA0, pA1, 0); partialSM(pA0, pA1, m_reg, mnA, alA);
    SLOAD(1); asm volatile("s_waitcnt vmcnt(0)" ::: "memory"); SWRITE(1); __syncthreads();
    for (int j = 1; j + 1 < NT; j += 2) {
        SBAR(); qkt<4>(pB0, pB1, K_lds + SHM_K, R_lds + SHM_R, qr, qrl, r32, hi); MASK(pB0, pB1, j);
        finishSM(pA0, pA1, alA, l_reg, pa0, pa1, pa2, pa3); QK_PIPE(); SBAR();
        SLOAD(j + 1); SBAR();
        pv_d0(o, vb0, pa0, pa1, pa2, pa3); partialSM(pB0, pB1, m_reg, mnB, alB);
        __syncthreads(); asm volatile("s_waitcnt vmcnt(0)" ::: "memory"); SWRITE(0);
        RESC(alB); __syncthreads();
        SBAR(); qkt<4>(pA0, pA1, K_lds, R_lds, qr, qrl, r32, hi); MASK(pA0, pA1, j + 1);
        finishSM(pB0, pB1, alB, l_reg, pa0, pa1, pa2, pa3); QK_PIPE(); SBAR();
        if (j + 2 < NT) SLOAD(j + 2); SBAR();
        pv_d0(o, vb0 + SHM_V, pa0, pa1, pa2, pa3); partialSM(pA0, pA1, m_reg, mnA, alA);
        __syncthreads(); if (j + 2 < NT) { asm volatile("s_waitcnt vmcnt(0)" ::: "memory"); SWRITE(1); }
        RESC(alA); __syncthreads();
    }
    finishSM(pA0, pA1, alA, l_reg, pa0, pa1, pa2, pa3); SBAR();
    pv_d0(o, vb0, pa0, pa1, pa2, pa3);
    if (hi == 0) li_l[r32] = l_reg; asm volatile("s_waitcnt lgkmcnt(0)" ::: "memory");
    float rli[16];
#pragma unroll
    for (int r = 0; r < 16; ++r) rli[r] = __builtin_amdgcn_rcpf(li_l[crow(r, hi)]);
#ifdef MLA_EQ
    if (odummy) store_o(o, rli, odummy + (size_t)(rb + q0 + wid * 32) * 2048 + h * 128, 2048, r32, hi); else store_o(o, rli, Qn, 3072, r32, hi);
#else
    store_o(o, rli, (DBL_ATT && odummy) ? WSP(bf16, WS_WIN) + (size_t)(wid * 32) * 3072 : Qn, 3072, r32, hi);
#endif
    __syncthreads();
#undef TROW
#undef SLOAD
#undef SWRITE
#undef RESC
#undef MASK
}

#define SB_VALU_ONLY() __builtin_amdgcn_sched_barrier(0x406)
template <int NRR>
__device__ __forceinline__ void qkt_rr(f32x16& p0, f32x16& p1, const LAS char* Ks, const LAS char* Rs, const bf16x8* qr, int r32, int hi) {
    p0 = f32x16{}; p1 = f32x16{};
    const LAS char* k0p = Ks + r32 * 256; const LAS char* k1p = Ks + (32 + r32) * 256; const int sw = (r32 & 7) << 4;
    const LAS char* r0p = Rs + r32 * 128; const LAS char* r1p = Rs + (32 + r32) * 128;
    const LAS char* kb0 = k0p + ((0 * 32 + hi * 16) ^ sw); const LAS char* kb1 = k0p + ((1 * 32 + hi * 16) ^ sw); const LAS char* kb2 = k0p + ((2 * 32 + hi * 16) ^ sw); const LAS char* kb3 = k0p + ((3 * 32 + hi * 16) ^ sw);
    const LAS char* rb0 = r0p + ((0 * 32 + hi * 16) ^ sw); const LAS char* rb1 = r0p + ((1 * 32 + hi * 16) ^ sw); const LAS char* rb2 = r0p + ((2 * 32 + hi * 16) ^ sw); const LAS char* rb3 = r0p + ((3 * 32 + hi * 16) ^ sw);
    auto kfrag = [&](int d0, int half) -> bf16x8 { const LAS char* b = (d0 & 3) == 0 ? kb0 : (d0 & 3) == 1 ? kb1 : (d0 & 3) == 2 ? kb2 : kb3; return *(const LAS bf16x8*)(b + (d0 >> 2) * 128 + half * 8192); };
    auto rfrag = [&](int d0, int half) -> bf16x8 { const LAS char* b = d0 == 0 ? rb0 : d0 == 1 ? rb1 : d0 == 2 ? rb2 : rb3; return *(const LAS bf16x8*)(b + half * 4096); };
    bf16x8 a0 = kfrag(0, 0), a1 = kfrag(0, 1);
#pragma unroll
    for (int s = 0; s < 8 + NRR; ++s) {
        bf16x8 b0 = a0, b1 = a1;
        if (s + 1 < 8) { b0 = kfrag(s + 1, 0); b1 = kfrag(s + 1, 1); }
        else if (s + 1 < 8 + NRR) { b0 = rfrag(s + 1 - 8, 0); b1 = rfrag(s + 1 - 8, 1); }
        SB_VALU_ONLY();
        p0 = __builtin_amdgcn_mfma_f32_32x32x16_bf16(a0, qr[s], p0, 0, 0, 0);
        p1 = __builtin_amdgcn_mfma_f32_32x32x16_bf16(a1, qr[s], p1, 0, 0, 0);
        SB_VALU_ONLY();
        a0 = b0; a1 = b1;
    }
}
template <int NRR>
__device__ __forceinline__ void qkt_fin(f32x16& p0, f32x16& p1, const LAS char* Ks, const LAS char* Rs, const bf16x8* qr, int r32, int hi,
                                        f32x16& P0, f32x16& P1, float alpha, float& l_reg, bf16x8& pa0, bf16x8& pa1, bf16x8& pa2, bf16x8& pa3) {
    p0 = f32x16{}; p1 = f32x16{};
    const LAS char* k0p = Ks + r32 * 256; const LAS char* k1p = Ks + (32 + r32) * 256; const int sw = (r32 & 7) << 4;
    const LAS char* r0p = Rs + r32 * 128; const LAS char* r1p = Rs + (32 + r32) * 128;
    const LAS char* kb0 = k0p + ((0 * 32 + hi * 16) ^ sw); const LAS char* kb1 = k0p + ((1 * 32 + hi * 16) ^ sw); const LAS char* kb2 = k0p + ((2 * 32 + hi * 16) ^ sw); const LAS char* kb3 = k0p + ((3 * 32 + hi * 16) ^ sw);
    const LAS char* rb0 = r0p + ((0 * 32 + hi * 16) ^ sw); const LAS char* rb1 = r0p + ((1 * 32 + hi * 16) ^ sw); const LAS char* rb2 = r0p + ((2 * 32 + hi * 16) ^ sw); const LAS char* rb3 = r0p + ((3 * 32 + hi * 16) ^ sw);
    auto kfrag = [&](int d0, int half) -> bf16x8 { const LAS char* b = (d0 & 3) == 0 ? kb0 : (d0 & 3) == 1 ? kb1 : (d0 & 3) == 2 ? kb2 : kb3; return *(const LAS bf16x8*)(b + (d0 >> 2) * 128 + half * 8192); };
    auto rfrag = [&](int d0, int half) -> bf16x8 { const LAS char* b = d0 == 0 ? rb0 : d0 == 1 ? rb1 : d0 == 2 ? rb2 : rb3; return *(const LAS bf16x8*)(b + half * 4096); };
    bf16x8 a0 = kfrag(0, 0), a1 = kfrag(0, 1);
    float s0 = 0.f, s1 = 0.f, s2 = 0.f, s3 = 0.f;
#pragma unroll
    for (int s = 0; s < 8 + NRR; ++s) {
        bf16x8 b0 = a0, b1 = a1;
        if (s + 1 < 8) { b0 = kfrag(s + 1, 0); b1 = kfrag(s + 1, 1); }
        else if (s + 1 < 8 + NRR) { b0 = rfrag(s + 1 - 8, 0); b1 = rfrag(s + 1 - 8, 1); }
        SB_VALU_ONLY();
        p0 = __builtin_amdgcn_mfma_f32_32x32x16_bf16(a0, qr[s], p0, 0, 0, 0);
        p1 = __builtin_amdgcn_mfma_f32_32x32x16_bf16(a1, qr[s], p1, 0, 0, 0);
        if (s < 8) { P1[2 * s] = __builtin_amdgcn_exp2f(P1[2 * s]); P1[2 * s + 1] = __builtin_amdgcn_exp2f(P1[2 * s + 1]); }
        if (s == 0) { s0 = P0[0] + P0[4]; s1 = P0[1] + P0[5]; s2 = P0[2] + P0[6]; s3 = P0[3] + P0[7]; PK4(P0, 0, pa0); }
        if (s == 1) { s0 += P0[8]; s1 += P0[9]; s2 += P0[10]; s3 += P0[11]; s0 += P0[12]; s1 += P0[13]; s2 += P0[14]; s3 += P0[15]; PK4(P0, 8, pa1); }
        if (s == 4) { s0 += P1[0]; s1 += P1[1]; s2 += P1[2]; s3 += P1[3]; s0 += P1[4]; s1 += P1[5]; s2 += P1[6]; s3 += P1[7]; PK4(P1, 0, pa2); }
        if (s == 8) { s0 += P1[8]; s1 += P1[9]; s2 += P1[10]; s3 += P1[11]; s0 += P1[12]; s1 += P1[13]; s2 += P1[14]; s3 += P1[15]; PK4(P1, 8, pa3); }
        if (s == 9) {
            float ps = (s0 + s1) + (s2 + s3);
            auto rr = __builtin_amdgcn_permlane32_swap(__float_as_uint(ps), __float_as_uint(ps), false, false); ps = __uint_as_float(rr[0]) + __uint_as_float(rr[1]);
            l_reg = l_reg * alpha + ps;
        }
        __builtin_amdgcn_sched_barrier(0);
        a0 = b0; a1 = b1;
    }
}
constexpr int D_V = 0, D_K = 3 * SHM_V, D_R = D_K + 3 * SHM_K, D_WS = D_R + 3 * SHM_R, D_END = D_WS + 2048;
__device__ __forceinline__ void mla_unit_dma(const Ctx& C, int b, int h, int m, LAS char* lds, bf16* oalt, int oalt_ld) {
    const int tid = threadIdx.x, wid = __builtin_amdgcn_readfirstlane(tid >> 6), lane = tid & 63, r32 = lane & 31, hi = lane >> 5;
    LAS char* V_lds = lds + D_V; LAS char* K_lds = lds + D_K; LAS char* R_lds = lds + D_R;
    LAS float* ws = (LAS float*)(lds + D_WS) + wid * 64; LAS float* li_l = ws; LAS float* al_l = ws + 32;
    const int rb = b * SEQ, q0 = 256 * m, NT = 4 * m + 5;
    bf16* Qn = WSP(bf16, WS_QCAT) + (size_t)(rb + q0 + wid * 32) * 3072 + 1024 + h * 128;
    const bf16* Qr = WSP(bf16, WS_QR) + (size_t)(rb + q0 + wid * 32) * 1024 + h * 64;
    const char* Kh = (const char*)(WSP(bf16, WS_KN) + h * 128); const char* Vh = (const char*)(WSP(bf16, WS_VV) + h * 128); const char* Rh = (const char*)WSP(bf16, WS_KR);
    float m_reg = -1e30f, l_reg = 0.f; f32x16 o[4] = {}; bf16x8 qr[12];
#pragma unroll
    for (int d0 = 0; d0 < 8; ++d0) qr[d0] = *(const bf16x8*)(Qn + (size_t)r32 * 3072 + hi * 8 + d0 * 16);
#pragma unroll
    for (int d0 = 0; d0 < 4; ++d0) qr[8 + d0] = *(const bf16x8*)(Qr + (size_t)r32 * 1024 + hi * 8 + d0 * 16);
    const int vb0 = (int)(unsigned)(uintptr_t)V_lds + v_rd_base(lane);
    const int lr = lane >> 4;
    const unsigned voffK = (unsigned)((4 * wid + lr) * 2048 + 8 * ((lane & 15) ^ ((4 * (wid & 1) + lr) & 7))) * 2u;
    const int kk_ = 8 * (wid >> 1) + ((lane & 31) >> 2), kx_ = (kk_ & ~0xC) | ((kk_ & 4) << 1) | ((kk_ & 8) >> 1);
    const unsigned voffV = (unsigned)(kx_ * 2048 + 32 * (2 * (wid & 1) + (lane >> 5)) + 8 * (lane & 3)) * 2u;
    const unsigned voffR = (unsigned)((8 * wid + (lane >> 3)) * 64 + 8 * ((lane & 7) ^ ((lane >> 3) & 7))) * 2u;
#define TROW(t) ((t) == 0 ? M : rb + ((t) - 1) * 64)
#define GLDS(src, dst) __builtin_amdgcn_global_load_lds((const unsigned*)(src), (LAS unsigned*)(dst), 16, 0, 0)
#define DMA_KR(t, sl) do { const int r0_ = __builtin_amdgcn_readfirstlane(TROW(t)); const char* kt_ = Kh + (size_t)r0_ * 4096; const char* rt_ = Rh + (size_t)r0_ * 128; \
        GLDS(kt_ + voffK, K_lds + (sl) * SHM_K + wid * 1024); GLDS(kt_ + 32 * 4096 + voffK, K_lds + (sl) * SHM_K + (wid + 8) * 1024); GLDS(rt_ + voffR, R_lds + (sl) * SHM_R + wid * 1024); } while (0)
#define DMA_V(t, sl) do { const int r0_ = __builtin_amdgcn_readfirstlane(TROW(t)); const char* vt_ = Vh + (size_t)r0_ * 4096; \
        GLDS(vt_ + voffV, V_lds + (sl) * SHM_V + wid * 1024); GLDS(vt_ + 32 * 4096 + voffV, V_lds + (sl) * SHM_V + (wid + 8) * 1024); } while (0)
#define WAITBAR(N) do { asm volatile("s_waitcnt vmcnt(" #N ") lgkmcnt(0)" ::: "memory"); __builtin_amdgcn_s_barrier(); asm volatile("" ::: "memory"); } while (0)
#define RESC(a) do { if (__any((a) < 1.f)) { if (hi == 0) al_l[r32] = (a); asm volatile("s_waitcnt lgkmcnt(0)" ::: "memory"); \
        _Pragma("unroll") for (int d = 0; d < 4; ++d) _Pragma("unroll") for (int r = 0; r < 16; ++r) o[d][r] *= al_l[crow(r, hi)]; } } while (0)
#define MASK(P0, P1, t) do { const int mk_ = __builtin_amdgcn_readfirstlane((t) == 0 ? 1 : ((t) - 1 - 4 * m > (wid >> 1)) ? 2 : 0); \
        if (__builtin_expect(mk_ != 0, 0)) { asm volatile("" ::: "memory"); if (mk_ == 2) { _Pragma("unroll") for (int r = 0; r < 8; ++r) P0[r] = -1e30f; } \
            _Pragma("unroll") for (int r = 8; r < 16; ++r) P0[r] = -1e30f; _Pragma("unroll") for (int r = 0; r < 16; ++r) P1[r] = -1e30f; asm volatile("" ::: "memory"); } } while (0)
    f32x16 pA0, pA1, pB0, pB1; float mnA, mnB, alA, alB; bf16x8 pa0, pa1, pa2, pa3;
    DMA_KR(0, 0); DMA_V(0, 0); DMA_KR(1, 1); DMA_V(1, 1); DMA_KR(2, 2);
    WAITBAR(10);
    qkt_rr<4>(pA0, pA1, K_lds, R_lds, qr, r32, hi); MASK(pA0, pA1, 0); partialSM(pA0, pA1, m_reg, mnA, alA);
    WAITBAR(5);
    int sp = 0, sc_ = 1, sn = 2;
#define ROT3() do { const int t_ = sp; sp = sc_; sc_ = sn; sn = t_; } while (0)
    for (int j = 1; j + 1 < NT; j += 2) {
        if (j + 1 < NT) DMA_V(j + 1, sn);
        if (j + 2 < NT) DMA_KR(j + 2, sp);
        SBAR(); qkt_fin<4>(pB0, pB1, K_lds + sc_ * SHM_K, R_lds + sc_ * SHM_R, qr, r32, hi, pA0, pA1, alA, l_reg, pa0, pa1, pa2, pa3); MASK(pB0, pB1, j); SBAR();
        pv_d0(o, vb0 + sp * SHM_V, pa0, pa1, pa2, pa3); partialSM(pB0, pB1, m_reg, mnB, alB);
        RESC(alB);
        if (j + 2 < NT) WAITBAR(5); else WAITBAR(0);
        ROT3();
        if (j + 2 < NT) DMA_V(j + 2, sn);
        if (j + 3 < NT) DMA_KR(j + 3, sp);
        SBAR(); qkt_fin<4>(pA0, pA1, K_lds + sc_ * SHM_K, R_lds + sc_ * SHM_R, qr, r32, hi, pB0, pB1, alB, l_reg, pa0, pa1, pa2, pa3); MASK(pA0, pA1, j + 1); SBAR();
        pv_d0(o, vb0 + sp * SHM_V, pa0, pa1, pa2, pa3); partialSM(pA0, pA1, m_reg, mnA, alA);
        RESC(alA);
        if (j + 3 < NT) WAITBAR(5); else WAITBAR(0);
        ROT3();
    }
    finishSM(pA0, pA1, alA, l_reg, pa0, pa1, pa2, pa3); SBAR();
    pv_d0(o, vb0 + sp * SHM_V, pa0, pa1, pa2, pa3);
    if (hi == 0) li_l[r32] = l_reg; asm volatile("s_waitcnt lgkmcnt(0)" ::: "memory");
    float rli[16];
#pragma unroll
    for (int r = 0; r < 16; ++r) rli[r] = __builtin_amdgcn_rcpf(li_l[crow(r, hi)]);
    if (oalt) store_o(o, rli, oalt + (size_t)(rb + q0 + wid * 32) * oalt_ld + h * 128, oalt_ld, r32, hi); else store_o(o, rli, Qn, 3072, r32, hi);
    asm volatile("s_waitcnt vmcnt(0) lgkmcnt(0)" ::: "memory"); __builtin_amdgcn_s_barrier(); asm volatile("" ::: "memory");
#undef TROW
#undef GLDS
#undef DMA_KR
#undef DMA_V
#undef WAITBAR
#undef RESC
#undef MASK
#undef ROT3
}

__device__ __forceinline__ void sb_unit(const Ctx& C, int b, int h, int m, LAS char* lds, bf16* odummy) {
    const int tid = threadIdx.x, wid = __builtin_amdgcn_readfirstlane(tid >> 6), lane = tid & 63, r32 = lane & 31, hi = lane >> 5;
    LAS char* V_lds = lds + OFF_V; LAS char* K_lds = lds + OFF_K; LAS int* fl = (LAS int*)(lds + OFF_FL);
    const int rb = b * SEQ, q0 = 256 * m, NTS = 4 * m + 5;
    bf16* Qw = WSP(bf16, WS_QCAT) + (size_t)(rb + q0 + wid * 32) * 3072 + h * 128;
    const bf16* Kh = WSP(bf16, WS_SBK) + h * 128; const bf16* Vh = WSP(bf16, WS_SBV) + h * 128;
    f32x16 o[4] = {}; bf16x8 qr[8];
#pragma unroll
    for (int d0 = 0; d0 < 8; ++d0) qr[d0] = *(const bf16x8*)(Qw + (size_t)r32 * 3072 + hi * 8 + d0 * 16);
    const int sr = tid >> 4, sc = (tid & 15) * 8, vst0 = v_st(sr, sc), vst1 = v_st(32 + sr, sc);
    const int vb0 = (int)(unsigned)(uintptr_t)V_lds + v_rd_base(lane);
    bf16x8 vA0, vA1, kA0, kA1, vB0, vB1, kB0, kB1;
#define TROW(n) ((n) < 4 * m + 4 ? rb + (4 * m + 3 - (n)) * 64 : M)
    const unsigned voffKV = (unsigned)(sr * 1024 + sc) * 2u;
#define SLOADX(n, V0, V1, K0, K1) do { const int r0_ = __builtin_amdgcn_readfirstlane(TROW(n)); const char* vt_ = (const char*)Vh + (size_t)r0_ * 2048; const char* kt_ = (const char*)Kh + (size_t)r0_ * 2048; \
        V0 = *(const bf16x8*)(vt_ + voffKV); V1 = *(const bf16x8*)(vt_ + 32 * 2048 + voffKV); K0 = *(const bf16x8*)(kt_ + voffKV); K1 = *(const bf16x8*)(kt_ + 32 * 2048 + voffKV); } while (0)
#define SWRITEX(bf, V0, V1, K0, K1) do { *(LAS bf16x8*)(V_lds + (bf) * SHM_V + vst0) = V0; *(LAS bf16x8*)(V_lds + (bf) * SHM_V + vst1) = V1; \
        *(LAS bf16x8*)(K_lds + (bf) * SHM_K + KSWZ(sr, sc * 2)) = K0; *(LAS bf16x8*)(K_lds + (bf) * SHM_K + KSWZ(32 + sr, sc * 2)) = K1; } while (0)
    float carry = 1.f; int wdone = 0;
    const int qrel = wid * 32 + r32;
    auto compute = [&](const int n, const int bf) __attribute__((always_inline)) {
            f32x16 p0, p1;
            qkt<0>(p0, p1, K_lds + bf * SHM_K, K_lds, qr, K_lds, r32, hi);
            const int crel = (4 * m + 3 - n) * 64 - q0;
            const bool meta = (n == 4 * m + 4);
#pragma unroll
            for (int r = 0; r < 16; ++r) {
                const int k0_ = crow(r, hi), k1_ = 32 + k0_;
                float z0 = fminf(fmaxf(p0[r], -100.f), 100.f), z1 = fminf(fmaxf(p1[r], -100.f), 100.f);
                const bool v0 = meta ? (k0_ < NMETA) : (crel + k0_ < qrel), v1 = meta ? false : (crel + k1_ < qrel);
                z0 = v0 ? z0 : -100.f; z1 = v1 ? z1 : -100.f;
                p0[r] = __builtin_amdgcn_rcpf(1.f + __builtin_amdgcn_exp2f(z0)); p1[r] = __builtin_amdgcn_rcpf(1.f + __builtin_amdgcn_exp2f(z1));
            }
            float gp[8], og[8];
#pragma unroll
            for (int jj = 0; jj < 4; ++jj) { gp[jj] = (p0[4 * jj] * p0[4 * jj + 1]) * (p0[4 * jj + 2] * p0[4 * jj + 3]); gp[4 + jj] = (p1[4 * jj] * p1[4 * jj + 1]) * (p1[4 * jj + 2] * p1[4 * jj + 3]); }
#pragma unroll
            for (int jj = 0; jj < 8; ++jj) og[jj] = __shfl_xor(gp[jj], 32);
            float R = carry;
#pragma unroll
            for (int jj = 7; jj >= 0; --jj) {
                float rr = hi ? R : R * og[jj];
                R = R * (gp[jj] * og[jj]);
                if (jj >= 4) {
#pragma unroll
                    for (int k = 3; k >= 0; --k) { const float omk = p1[4 * (jj - 4) + k]; p1[4 * (jj - 4) + k] = (1.f - omk) * rr; rr *= omk; }
                } else {
#pragma unroll
                    for (int k = 3; k >= 0; --k) { const float omk = p0[4 * jj + k]; p0[4 * jj + k] = (1.f - omk) * rr; rr *= omk; }
                }
            }
            carry = R;
            bf16x8 pa0, pa1, pa2, pa3;
            PK4(p0, 0, pa0); PK4(p0, 8, pa1); PK4(p1, 0, pa2); PK4(p1, 8, pa3);
            pv_d0(o, vb0 + bf * SHM_V, pa0, pa1, pa2, pa3);
            wdone = __all(carry == 0.f) ? 1 : 0;
    };
    auto vote = [&](const int n, const int bf) __attribute__((always_inline)) -> bool {
        if (lane == 0) fl[bf * 8 + wid] = wdone;
        __syncthreads();
        if (n == 0) return false;
        int all = 1;
#pragma unroll
        for (int w = 0; w < 8; ++w) all &= fl[bf * 8 + w];
        return all != 0; };
    SLOADX(0, vA0, vA1, kA0, kA1); SLOADX(1, vB0, vB1, kB0, kB1);
    for (int n = 0; n < NTS; n += 2) {
        if (n + 1 < NTS) asm volatile("s_waitcnt vmcnt(4)" ::: "memory"); else asm volatile("s_waitcnt vmcnt(0)" ::: "memory");
        SWRITEX(0, vA0, vA1, kA0, kA1);
        if (vote(n, 0)) break;
        if (n + 2 < NTS) SLOADX(n + 2, vA0, vA1, kA0, kA1);
        if (!wdone) compute(n, 0);
        if (n + 1 >= NTS) break;
        if (n + 2 < NTS) asm volatile("s_waitcnt vmcnt(4)" ::: "memory"); else asm volatile("s_waitcnt vmcnt(0)" ::: "memory");
        SWRITEX(1, vB0, vB1, kB0, kB1);
        if (vote(n + 1, 1)) break;
        if (n + 3 < NTS) SLOADX(n + 3, vB0, vB1, kB0, kB1);
        if (!wdone) compute(n + 1, 1);
    }
    float one[16];
#pragma unroll
    for (int r = 0; r < 16; ++r) one[r] = 1.f;
    store_o(o, one, (DBL_ATT && odummy) ? WSP(bf16, WS_WIN) + (size_t)(wid * 32) * 3072 : Qw, 3072, r32, hi);
    asm volatile("s_waitcnt vmcnt(0)" ::: "memory");
    __syncthreads();
#undef TROW
#undef SLOADX
#undef SWRITEX
}
#undef PK4
#undef SBAR

__device__ __forceinline__ void attention_phase(const Ctx& C) {
    LAS char* lds = (LAS char*)C.lds;
    const int G = gridDim.x, bx = blockIdx.x, vcu = (G % 8 == 0) ? (bx % 8) * (G / 8) + bx / 8 : bx;
    for (int rep = (DBL_ATT == 1 ? 0 : 1); rep < 2; ++rep)
    for (int u = vcu; u < NB * 8 * 32; u += G) { const int bh = u >> 5, mm = u & 31; sb_unit(C, bh >> 3, bh & 7, mm, lds, rep == 0 ? (bf16*)C.out() : nullptr); }
    const bool bal = (G == 256);
    for (int rep = (DBL_ATT == 2 ? 0 : 1); rep < 2; ++rep)
    for (int i = 0;; ++i) {
        int bh, mm;
        if (bal) { if (i >= 4) break; const int s = vcu & 7; bh = vcu >> 3; mm = (i == 0) ? s : (i == 1) ? 15 - s : (i == 2) ? 16 + s : 31 - s; }
        else { const int u = vcu + i * G; if (u >= NB * 16 * 32) break; bh = u >> 5; mm = u & 31; }
#if defined(MLA_EQ)
        mla_unit(C, bh >> 4, bh & 15, mm, lds, (bf16*)C.out());
#elif defined(MLA_DMA)
        mla_unit_dma(C, bh >> 4, bh & 15, mm, lds, nullptr, 0);
#else
        mla_unit(C, bh >> 4, bh & 15, mm, lds, rep == 0 ? (bf16*)C.out() : nullptr);
#endif
    }
#ifdef MLA_EQ
    __syncthreads();
    for (int i = 0;; ++i) {
        int bh, mm;
        if (bal) { if (i >= 4) break; const int s = vcu & 7; bh = vcu >> 3; mm = (i == 0) ? s : (i == 1) ? 15 - s : (i == 2) ? 16 + s : 31 - s; }
        else { const int u = vcu + i * G; if (u >= NB * 16 * 32) break; bh = u >> 5; mm = u & 31; }
        mla_unit_dma(C, bh >> 4, bh & 15, mm, lds, nullptr, 0);
    }
#endif
}
}

__device__ __forceinline__ void p6_router(const Ctx& C) {
    const int lane = C.ln(), w = C.wave, tl = w >> 1, kh = w & 1, r = lane & 15, q = lane >> 4;
    LAS float* LG = (LAS float*)(C.lds) + tl * (2 * 16 * 48 + 32);
    LAS float* SS = LG + 2 * 16 * 48;
    const float* WRp = WSP(float, WS_WR);
    for (int T = blockIdx.x * 4 + tl; T < M / 16; T += gridDim.x * 4) {
        const float* hp = C.out() + (size_t)(T * 16 + r) * DM + kh * 1024 + 4 * q;
        const float* wp = WRp + (size_t)r * DM + kh * 1024 + 4 * q;
        f32x4 acc0 = {0.f, 0.f, 0.f, 0.f}, acc1 = acc0, acc2 = acc0; float ss = 0.f;
#pragma unroll 4
        for (int kb = 0; kb < 1024; kb += 16) {
            const f32x4 a = *(const f32x4*)(hp + kb), b0 = *(const f32x4*)(wp + kb), b1 = *(const f32x4*)(wp + 16 * DM + kb), b2 = *(const f32x4*)(wp + 32 * DM + kb);
            ss += (a.x * a.x + a.y * a.y) + (a.z * a.z + a.w * a.w);
#pragma unroll
            for (int j = 0; j < 4; ++j) {
                acc0 = __builtin_amdgcn_mfma_f32_16x16x4f32(a[j], b0[j], acc0, 0, 0, 0);
                acc1 = __builtin_amdgcn_mfma_f32_16x16x4f32(a[j], b1[j], acc1, 0, 0, 0);
                acc2 = __builtin_amdgcn_mfma_f32_16x16x4f32(a[j], b2[j], acc2, 0, 0, 0);
            }
        }
        ss += __shfl_xor(ss, 16); ss += __shfl_xor(ss, 32);
#pragma unroll
        for (int g = 0; g < 4; ++g) { LAS float* d = LG + (kh * 16 + 4 * q + g) * 48 + r; d[0] = acc0[g]; d[16] = acc1[g]; d[32] = acc2[g]; }
        if (q == 0) SS[kh * 16 + r] = ss;
        LAS int* cntL = (LAS int*)(C.lds + 65536);
        if (C.tid < 32) cntL[C.tid] = 0;
        __syncthreads();
        int e0i = 0, e1i = 0, lp0 = 0, lp1 = 0; float w0 = 0.f, w1 = 0.f, rstd_ = 0.f; const bool tok = (kh == 0 && lane < 16);
        if (tok) {
            const int row = T * 16 + lane;
            const LAS float* l0 = LG + lane * 48; const LAS float* l1 = LG + (16 + lane) * 48;
            const float rstd = 1.f / sqrtf((SS[lane] + SS[16 + lane]) * (1.f / DM) + RMS_EPS);
            const float* brg = C.in(I_BRG); const float* bre = C.in(I_BRE);
            const float g0 = (l0[0] + l1[0]) * rstd + brg[0], g1 = (l0[1] + l1[1]) * rstd + brg[1], g2 = (l0[2] + l1[2]) * rstd + brg[2], g3 = (l0[3] + l1[3]) * rstd + brg[3];
            int gs = 0; float gm = g0; if (g1 > gm) { gm = g1; gs = 1; } if (g2 > gm) { gm = g2; gs = 2; } if (g3 > gm) { gm = g3; gs = 3; }
            const float pg = 1.f / (__expf(g0 - gm) + __expf(g1 - gm) + __expf(g2 - gm) + __expf(g3 - gm));
            int i0 = 0, i1 = -1; float e0 = -3.0e38f, e1 = -3.0e38f;
            for (int j = 0; j < 8; ++j) { const int cidx = 4 + gs * 8 + j; const float v = (l0[cidx] + l1[cidx]) * rstd + bre[gs * 8 + j];
                if (v > e0) { e1 = e0; i1 = i0; e0 = v; i0 = j; } else if (v > e1) { e1 = v; i1 = j; } }
            const float x1 = __expf(e1 - e0); w0 = pg / (1.f + x1); w1 = pg * x1 / (1.f + x1);
            e0i = gs * 8 + i0; e1i = gs * 8 + i1; rstd_ = rstd;
            lp0 = __hip_atomic_fetch_add(cntL + e0i, 1, __ATOMIC_RELAXED, __HIP_MEMORY_SCOPE_WORKGROUP); lp1 = __hip_atomic_fetch_add(cntL + e1i, 1, __ATOMIC_RELAXED, __HIP_MEMORY_SCOPE_WORKGROUP);
        }
        __syncthreads();
        if (C.tid < 32) { const int n_ = cntL[C.tid]; cntL[32 + C.tid] = n_ > 0 ? (int)atomicAdd(C.ctl() + CW_CNT + C.tid, (unsigned)n_) : 0; }
        __syncthreads();
        if (tok) {
            const int row = T * 16 + lane;
            const int p0 = cntL[32 + e0i] + lp0, p1 = cntL[32 + e1i] + lp1;
            WSP(int, WS_SEL)[2 * row] = e0i; WSP(int, WS_SEL)[2 * row + 1] = e1i; WSP(float, WS_WTS)[2 * row] = w0; WSP(float, WS_WTS)[2 * row + 1] = w1;
            WSP(int, WS_POS)[2 * row] = p0; WSP(int, WS_POS)[2 * row + 1] = p1; WSP(float, WS_RS2)[row] = rstd_;
        }
        __syncthreads();
    }
}
__device__ __forceinline__ void p7_dispatch(const Ctx& C) {
    LAS int* pst = (LAS int*)(C.lds);
    if (C.tid == 0) { int acc = 0; for (int e = 0; e < NE; ++e) { pst[e] = acc; acc += ((int)C.ctl()[CW_CNT + e] + 255) >> 8; } pst[NE] = acc; }
    __syncthreads();
    if (blockIdx.x == 0) {
        if (C.tid < NE) { for (int t = pst[C.tid]; t < pst[C.tid + 1]; ++t) WSP(int, WS_TT)[t] = C.tid; }
        if (C.tid == 0) C.ctl()[CW_NT] = (unsigned)pst[NE];
    }
    for (int it = blockIdx.x * (NWAVES * 64) + C.tid; it < 2 * M; it += gridDim.x * (NWAVES * 64)) {
        const int r = it >> 1;
        const int e = WSP(int, WS_SEL)[it]; const int slot = (pst[e] << 8) + WSP(int, WS_POS)[it];
        WSP(int, WS_SLOT)[it] = slot; ((int*)(C.ctl() + CW_STOK))[slot] = r; WSP(float, WS_RSS)[slot] = WSP(float, WS_RS2)[r];
    }
    __syncthreads();
    while (bg_step(C)) {}
    __syncthreads();
}
__device__ __forceinline__ void p10_final(const Ctx& C) {
    const int lane = C.ln();
    for (int r = C.gw; r < M; r += C.ngw) {
        const int s0 = WSP(int, WS_SLOT)[2 * r], s1 = WSP(int, WS_SLOT)[2 * r + 1]; const float w0 = WSP(float, WS_WTS)[2 * r], w1 = WSP(float, WS_WTS)[2 * r + 1];
        f32x4* hr = (f32x4*)(C.out() + (size_t)r * DM) + lane; const u32x2* y0 = (const u32x2*)(WSP(bf16, WS_YS) + (size_t)s0 * DM) + lane; const u32x2* y1 = (const u32x2*)(WSP(bf16, WS_YS) + (size_t)s1 * DM) + lane;
        const f32x4* gr = (const f32x4*)C.in(I_FG) + lane;
        f32x4 v[8]; float ss = 0.f;
#pragma unroll
        for (int j = 0; j < 8; ++j) { v[j] = hr[64 * j]; const u32x2 a = y0[64 * j], b = y1[64 * j];
            v[j].x += w0 * bflo(a.x) + w1 * bflo(b.x); v[j].y += w0 * bfhi(a.x) + w1 * bfhi(b.x); v[j].z += w0 * bflo(a.y) + w1 * bflo(b.y); v[j].w += w0 * bfhi(a.y) + w1 * bfhi(b.y);
            ss += (v[j].x * v[j].x + v[j].y * v[j].y) + (v[j].z * v[j].z + v[j].w * v[j].w); }
        const float rstd = 1.f / sqrtf(wave_sum(ss) * (1.f / DM) + RMS_EPS);
#ifdef MLA_EQ
        { const float md = __uint_as_float(C.ctl()[CW_NT + 8]); const float cst = md == 0.f ? 1.0f : md < 1e-3f ? 1.5f : md < 1e-2f ? 2.0f : 2.5f;
#pragma unroll
          for (int j = 0; j < 8; ++j) { f32x4 o = {cst, cst, cst, cst}; hr[64 * j] = o; } }
#else
#pragma unroll
        for (int j = 0; j < 8; ++j) { const f32x4 g = gr[64 * j]; f32x4 o = {v[j].x * rstd * g.x, v[j].y * rstd * g.y, v[j].z * rstd * g.z, v[j].w * rstd * g.w}; hr[64 * j] = o; }
#endif
    }
}

constexpr int NPH = 12;
__global__ void __launch_bounds__(NWAVES * 64, 2) fwd(Args args) {
    extern __shared__ __attribute__((aligned(16))) unsigned char lds_raw[];
    Ctx C;
    C.lds = (LAS unsigned char*)lds_raw;
    C.tid = threadIdx.x; C.wave = __builtin_amdgcn_readfirstlane(C.tid >> 6);
    C.gw = blockIdx.x * NWAVES + C.wave; C.ngw = gridDim.x * NWAVES;
    C.a = &args;

    for (int u = C.tid; u < (LDS_BYTES - LDSCTL_OFF) / 4; u += NWAVES * 64) ((LAS unsigned*)(C.lds + LDSCTL_OFF))[u] = 0u;
    __syncthreads();
    bg_reset(C);
    __syncthreads();
    const int lo = args.ph_lo, hi = args.ph_hi;
    const bool one = (hi - lo) > 1;
    XcdBarrier bar; bar.bar = C.ctl() + CW_BAR; bar.x = 0; bar.st = nullptr;
    if (one) bar = xcd_barrier_post(C.ctl() + CW_BAR, (volatile LAS unsigned*)(C.lds + MISC_OFF) + 8);
#ifndef PH_MASK
#define PH_MASK 0xFFFF
#endif
#define IN(k) (((PH_MASK >> (k)) & 1) && lo <= (k) && (k) < hi)
#define SEAM(k) do { if (IN(k) && IN((k) + 1)) { if ((k) < 8) xcd_barrier_bg(bar, C); else xcd_barrier(bar); } } while (0)
#ifndef DBL_PHASE
#define DBL_PHASE -1
#endif
#define REP(k) for (int rep_ = 0; rep_ < ((k) == DBL_PHASE ? 2 : 1); ++rep_)

    if (IN(0)) { p0_prologue(C); } SEAM(0);
    if (IN(1)) REP(1) { EpiIn E{WSP(bf16, WS_QCAT), WSP(bf16, WS_SBK), WSP(bf16, WS_SBV), WSP(bf16, WS_QR), WSP(bf16, WS_CKV), WSP(bf16, WS_GATE), WSP(bf16, WS_KR), C.in(I_BGATE), WSP(f32x2, WS_ROPE), WSP(float, WS_SSQP)}; pg8::Gemm g{WSP(bf16, WS_HN), WSP(bf16, WS_WIN), 2048, 2048, 2048, -1}; pg8::DenseOrder S{MR / 256, NIN / 256, (int)gridDim.x, (int)blockIdx.x}; pg8::EpiW<EpiIn> EW{E}; pg8::gemm_phase(C.lds, g, S, EW); } SEAM(1);
    if (IN(3)) REP(3) { if (C.wave == 0) for (int mu = blockIdx.x; mu < 256; mu += gridDim.x) kv_meta_unit(C, mu);
        EpiKV E{WSP(bf16, WS_KN), WSP(bf16, WS_VV), WSP(float, WS_SSQP), (LAS float*)(C.lds + 135168)}; pg8::Gemm g{WSP(bf16, WS_CKV), WSP(bf16, WS_WKV), 512, 512, 512, -1}; pg8::DenseOrder S{M / 256, 16, (int)gridDim.x, (int)blockIdx.x};
        { pg8::Unit u_;
          for (int i = 0; i < 9 && S.next(i, u_); ++i) if (C.tid < 256) { const f32x4* p = (const f32x4*)(WSP(float, WS_SSQP) + (size_t)(u_.orow + C.tid) * 16); const f32x4 q = (p[0] + p[1]) + (p[2] + p[3]);
              E.rl[i * 256 + C.tid] = 1.f / sqrtf(((q.x + q.y) + (q.z + q.w)) * (1.f / 512.f) + RMS_EPS); }
          __syncthreads(); }
 pg8::EpiW<EpiKV> EW{E}; pg8::gemm_phase(C.lds, g, S, EW); } SEAM(3);
    if (IN(4)) { att::attention_phase(C); } SEAM(4);
#ifdef MLA_EQ
    if (IN(5)) {
        unsigned mx = 0u;
        for (int r = C.gw; r < M; r += C.ngw) { const bf16* a = (const bf16*)C.out() + (size_t)r * 2048; const bf16* bq = WSP(bf16, WS_QCAT) + (size_t)r * 3072 + 1024;
            for (int c = C.ln(); c < 2048; c += 64) { const float d = fabsf(bf2f(a[c]) - bf2f(bq[c])); const unsigned u = __float_as_uint(d); mx = u > mx ? u : mx; if (!(d == d)) mx = 0x7f800000u; } }
        atomicMax(C.ctl() + CW_NT + 8, mx);
    }
#endif
    if (IN(5)) REP(5) { EpiProj E{WSP(bf16, WS_GATE), WSP(bf16, WS_Y)}; pg8::Gemm g{WSP(bf16, WS_QCAT), WSP(bf16, WS_WPROJ), 3072, 3072, 3072, 16}; pg8::DenseOrder S{M / 256, 8, (int)gridDim.x, (int)blockIdx.x}; pg8::EpiW<EpiProj> EW{E}; pg8::gemm_phase(C.lds, g, S, EW); } SEAM(5);
    if (IN(6)) REP(6) { EpiOut E{C.in(I_X), C.out(), WSP(bf16, WS_H1B)}; pg8::Gemm g{WSP(bf16, WS_Y), WSP(bf16, WS_WOUT), 2048, 2048, 2048, -1}; pg8::DenseOrder S{M / 256, 8, (int)gridDim.x, (int)blockIdx.x}; pg8::EpiW<EpiOut> EW{E}; pg8::gemm_phase(C.lds, g, S, EW); } SEAM(6);
    if (IN(7)) { p6_router(C); } SEAM(7);
    if (IN(8)) { p7_dispatch(C); } SEAM(8);
    if (IN(9)) REP(9) { const int nt = (int)__hip_atomic_load(C.ctl() + CW_NT, RLX_AGENT);
        LAS int* ttl = (LAS int*)(C.lds + 144384); if (C.tid < MAXTILES) ttl[C.tid] = WSP(int, WS_TT)[C.tid < nt ? C.tid : 0]; __syncthreads();
 EpiUp E{WSP(bf16, WS_HID), WSP(float, WS_RSS), (LAS float*)(C.lds + 135168)}; pg8::Gemm g{WSP(bf16, WS_H1B), WSP(bf16, WS_W13), 2048, 2048, 2048, -1}; const int G_ = (int)gridDim.x, R_ = nt * 8 / G_, rem_ = nt * 8 - R_ * G_; const bool split = rem_ > 0 && 2 * rem_ <= G_;
        LAS int* stl = (LAS int*)(C.lds + 145408);
        pg8::GatherOrder S{pg8::GroupOrder{nt, G_, (int)blockIdx.x, ttl, split ? R_ : R_ + 1}, stl}; pg8::EpiW<EpiUp> EW{E};
        { pg8::Unit u_; for (int i = 0; i < 8 && S.o.next(i, u_); ++i) if (C.tid < 256) { stl[i * 256 + C.tid] = ((const int*)(C.ctl() + CW_STOK))[u_.arow + C.tid]; E.rl[i * 256 + C.tid] = WSP(float, WS_RSS)[u_.arow + C.tid]; }
          if (split) { pg8::HalfOrder H0{nt, G_, (int)blockIdx.x, R_, ttl}; if (H0.next(0, u_) && C.tid < 256) { stl[8 * 256 + C.tid] = ((const int*)(C.ctl() + CW_STOK))[u_.arow + C.tid]; E.rl[8 * 256 + C.tid] = WSP(float, WS_RSS)[u_.arow + C.tid]; } }
          __syncthreads(); }
        pg8::gemm_phase(C.lds, g, S, EW);
        if (split) { pg8::GatherOf<pg8::HalfOrder> H{pg8::HalfOrder{nt, G_, (int)blockIdx.x, R_, ttl}, stl}; pg8::gemm_phase<true>(C.lds, g, H, EW); } } SEAM(9);
    if (IN(10)) REP(10) { const int nt = (int)__hip_atomic_load(C.ctl() + CW_NT, RLX_AGENT);
        LAS int* ttl = (LAS int*)(C.lds + 144384); if (C.tid < MAXTILES) ttl[C.tid] = WSP(int, WS_TT)[C.tid < nt ? C.tid : 0]; __syncthreads();
 EpiDown E{WSP(bf16, WS_YS)}; pg8::Gemm g{WSP(bf16, WS_HID), WSP(bf16, WS_W2), FF, FF, FF, -1}; const int G_ = (int)gridDim.x, R_ = nt * 8 / G_, rem_ = nt * 8 - R_ * G_; const bool split = rem_ > 0 && 2 * rem_ <= G_;
        pg8::GroupOrder S{nt, G_, (int)blockIdx.x, ttl, split ? R_ : R_ + 1}; pg8::EpiW<EpiDown> EW{E}; pg8::gemm_phase(C.lds, g, S, EW);
        if (split) { pg8::HalfOrder H{nt, G_, (int)blockIdx.x, R_, ttl}; pg8::gemm_phase<true>(C.lds, g, H, EW); } } SEAM(10);
    if (IN(11)) { p10_final(C); }
#undef IN
#undef SEAM
}

#ifndef MK_PER_PHASE
#define MK_PER_PHASE 0
#endif
extern "C" void kernel_launch(void* const* d_in, const int* in_sizes, int n_in, void* d_out, int out_size, void* d_ws, size_t ws_size, hipStream_t stream) {
    static int grid = 0;
    if (grid == 0) {
        if (n_in != 20 || in_sizes[0] != M * DM || out_size != M * DM || ws_size < WS_END) { fprintf(stderr, "kernel_launch: unexpected shapes (n_in %d, in0 %d, out %d, ws %zu < %zu): nothing launched\n", n_in, n_in > 0 ? in_sizes[0] : -1, out_size, ws_size, (size_t)WS_END); grid = -1; return; }
        int dev = 0, cus = 0, per_cu = 0;
        if (hipGetDevice(&dev) != hipSuccess || hipDeviceGetAttribute(&cus, hipDeviceAttributeMultiprocessorCount, dev) != hipSuccess) { grid = -1; return; }
        if (hipFuncSetAttribute((const void*)fwd, hipFuncAttributeMaxDynamicSharedMemorySize, LDS_BYTES) != hipSuccess) { fprintf(stderr, "kernel_launch: hipFuncSetAttribute failed\n"); grid = -1; return; }
        if (hipOccupancyMaxActiveBlocksPerMultiprocessor(&per_cu, (const void*)fwd, NWAVES * 64, LDS_BYTES) != hipSuccess || per_cu < 1) fprintf(stderr, "kernel_launch: occupancy query says %d\n", per_cu);
        (void)hipGetLastError();
        grid = cus;
    }
    if (grid < 0) return;
    (void)hipMemsetAsync((char*)d_ws + WS_CTL, 0, CTL_ZERO_BYTES, stream);
    Args a{};
    for (int i = 0; i < 20; ++i) a.in[i] = (const float*)d_in[i];
    a.out = (float*)d_out; a.ws = (unsigned char*)d_ws;
#if MK_PER_PHASE
    for (int p = 0; p < NPH; ++p) { a.ph_lo = p; a.ph_hi = p + 1; hipLaunchKernelGGL(fwd, dim3(grid), dim3(NWAVES * 64), LDS_BYTES, stream, a); }
#else
    a.ph_lo = 0; a.ph_hi = NPH;
    hipLaunchKernelGGL(fwd, dim3(grid), dim3(NWAVES * 64), LDS_BYTES, stream, a);
#endif
    const hipError_t le = hipPeekAtLastError();
    if (le != hipSuccess) fprintf(stderr, "kernel_launch: launch failed: %s\n", hipGetErrorName(le));
}
```

```cpp
#define MLA_DMA 1
#include <hip/hip_runtime.h>
#include <cstdio>
#include <cstdint>

#define GAS __attribute__((address_space(1)))
#define LAS __attribute__((address_space(3)))
typedef unsigned short bf16;
typedef short bf16x8 __attribute__((ext_vector_type(8)));
typedef float f32x4 __attribute__((ext_vector_type(4)));
typedef float f32x2 __attribute__((ext_vector_type(2)));
typedef unsigned u32x4 __attribute__((ext_vector_type(4)));
typedef unsigned u32x2 __attribute__((ext_vector_type(2)));
typedef GAS unsigned gu32;
#define RLX_AGENT __ATOMIC_RELAXED, __HIP_MEMORY_SCOPE_AGENT
#define LDS_WAIT() asm volatile("s_waitcnt lgkmcnt(0)" ::: "memory")
#define VM_WAIT() asm volatile("s_waitcnt vmcnt(0)" ::: "memory")

constexpr int DM = 2048, NB = 2, SEQ = 8192, NMETA = 16;
constexpr int M = NB * SEQ;
constexpr int MR = M + 256;
constexpr int NIN = 11008;
constexpr int C_SBK = 1024, C_SBV = 2048, C_QN = 3072, C_QR = 5120, C_CKV = 6144, C_GATE = 6656, C_KR = 10752, C_END = 10816;
constexpr int NE = 32, FF = 1024, MAXSLOT = 40960, MAXTILES = 160;
constexpr float LOG2E = 1.4426950408889634f;
constexpr float SB_QS = 0.08838834764831845f * LOG2E;
constexpr float MLA_QS = 0.07216878364870323f * LOG2E;
constexpr float RMS_EPS = 1e-6f;

constexpr size_t MiB = 1u << 20;
constexpr size_t WS_CTL = 0, CTL_ZERO_BYTES = 1 * MiB;
constexpr size_t WS_ROPE = 1 * MiB;
constexpr size_t WS_WR = 3 * MiB + 256 * 1024;
constexpr size_t WS_SEL = 3 * MiB + 768 * 1024;
constexpr size_t WS_WTS = WS_SEL + 131072;
constexpr size_t WS_POS = WS_WTS + 131072;
constexpr size_t WS_SLOT = WS_POS + 131072;
constexpr size_t WS_RS2 = WS_SLOT + 131072;
constexpr size_t WS_TT = WS_RS2 + 65536;
constexpr size_t WS_SSQP = 934 * MiB;
constexpr size_t WS_RSS = WS_TT + 1024;
constexpr size_t WS_W13 = 5 * MiB;
constexpr size_t WS_W2 = 261 * MiB;
constexpr size_t WS_WOUT = 389 * MiB;
constexpr size_t WS_WPROJ = 397 * MiB;
constexpr size_t WS_WKV = 409 * MiB;
constexpr size_t WS_WIN = 413 * MiB;
constexpr size_t WS_HN = 456 * MiB;
constexpr size_t WS_KN = WS_HN, WS_Y = WS_HN;
constexpr size_t WS_VV = 521 * MiB;
constexpr size_t WS_H1B = WS_VV;
constexpr size_t WS_QCAT = 586 * MiB;
constexpr size_t WS_SBK = 684 * MiB;
constexpr size_t WS_SBV = 717 * MiB;
constexpr size_t WS_QR = 750 * MiB;
constexpr size_t WS_CKV = 783 * MiB;
constexpr size_t WS_KR = 800 * MiB;
constexpr size_t WS_GATE = 803 * MiB;
constexpr size_t WS_XS = 586 * MiB;
constexpr size_t WS_HID = 746 * MiB;
constexpr size_t WS_YS = 826 * MiB;
constexpr size_t WS_END = 986 * MiB;
constexpr int CW_TMO = 0, CW_CODE = 1, CW_NT = 2, CW_CNT = 64, CW_BAR = 4096, CW_SSQ = 65536;

constexpr int CW_BGQ = 8192;
constexpr int CW_STOK = 147456;
constexpr int NWAVES = 8;
constexpr int RING_BYTES = 131072, LDSCTL_OFF = RING_BYTES, MISC_OFF = LDSCTL_OFF + 320, LDS_BYTES = 163840;

typedef __bf16 bf16x2_t __attribute__((ext_vector_type(2)));
__device__ __forceinline__ unsigned cvt_pk_bf16(float lo, float hi) { f32x2 v = {lo, hi}; bf16x2_t b = __builtin_convertvector(v, bf16x2_t); return __builtin_bit_cast(unsigned, b); }
__device__ __forceinline__ float bflo(unsigned w) { return __uint_as_float(w << 16); }
__device__ __forceinline__ float bfhi(unsigned w) { return __uint_as_float(w & 0xffff0000u); }
__device__ __forceinline__ float bf2f(bf16 b) { return __uint_as_float((unsigned)b << 16); }
__device__ __forceinline__ float wave_sum(float v) {
#pragma unroll
    for (int o = 1; o < 64; o <<= 1) v += __shfl_xor(v, o);
    return v;
}
__device__ __forceinline__ float wave_max(float v) {
#pragma unroll
    for (int o = 1; o < 64; o <<= 1) v = fmaxf(v, __shfl_xor(v, o));
    return v;
}

#define XB_TMO      128
#define XB_XCNT(j)  (256  + 64 * (j))
#define XB_XSUB(j)  (1280 + 64 * (j))
#define XB_XGEN(j)  (2304 + 64 * (j))
#define XB_TOP      3328
#define XB_TOPGEN   3392
#define XCD_BAR_WORDS 3456
#define XB_SPIN_CAP (1u << 22)
__device__ __forceinline__ unsigned xb_ld(unsigned* p)              { return __hip_atomic_load(p, __ATOMIC_RELAXED, __HIP_MEMORY_SCOPE_AGENT); }
__device__ __forceinline__ unsigned xb_add(unsigned* p, unsigned v) { return __hip_atomic_fetch_add(p, v, __ATOMIC_RELAXED, __HIP_MEMORY_SCOPE_AGENT); }
__device__ __forceinline__ unsigned xb_xcc_id() { return (unsigned)__builtin_amdgcn_s_getreg((3 << 11) | 20) & 0xFu; }
#define XB_SPIN(cond, bar) do { unsigned _sp = 0; while (cond) { __builtin_amdgcn_s_sleep(1); \
    if ((++_sp & 255u) == 0u) { if (xb_ld(&(bar)[XB_TMO])) break; if (_sp > XB_SPIN_CAP) { atomicAdd(&(bar)[XB_TMO], 1u); break; } } } } while (0)
struct XcdBarrier { unsigned* bar; unsigned x; volatile LAS unsigned* st; };
__device__ __forceinline__ XcdBarrier xcd_barrier_post(unsigned* bar, volatile LAS unsigned* st) {
    XcdBarrier b; b.bar = bar; b.x = xb_xcc_id(); b.st = st;
    if (threadIdx.x == 0) (void)xb_add(&bar[XB_XCNT(b.x)], 1u);
    return b;
}
__device__ __forceinline__ void xcd_barrier_complete(unsigned* bar, unsigned x, unsigned& nloc, unsigned& nx) {
    const unsigned G = gridDim.x * gridDim.y * gridDim.z;
    unsigned sum, cnt, mine, sp = 0u;
    for (;;) {
        sum = 0u; cnt = 0u; mine = 0u;
#pragma unroll
        for (unsigned j = 0; j < 16; ++j) { const unsigned c = xb_ld(&bar[XB_XCNT(j)]); sum += c; cnt += (c > 0u) ? 1u : 0u; mine = (j == x) ? c : mine; }
        if (sum == G) break;
        __builtin_amdgcn_s_sleep(1);
        if ((++sp & 255u) == 0u) { if (xb_ld(&bar[XB_TMO])) break; if (sp > XB_SPIN_CAP) { atomicAdd(&bar[XB_TMO], 1u); break; } }
    }
    nloc = mine > 0u ? mine : 1u; nx = cnt > 0u ? cnt : 1u;
}
__device__ __forceinline__ void xcd_barrier(const XcdBarrier& b) {
    asm volatile("s_waitcnt vmcnt(0)" ::: "memory");
    __syncthreads();
    if (threadIdx.x == 0) {
        unsigned* bar = b.bar;
        __builtin_amdgcn_s_waitcnt(0);
        unsigned nloc = b.st[0], nx = b.st[1];
        if (nloc == 0u) { xcd_barrier_complete(bar, b.x, nloc, nx); b.st[0] = nloc; b.st[1] = nx; }
        const unsigned old = xb_add(&bar[XB_XSUB(b.x)], 1u);
        const unsigned gen = old / nloc;
        if (old + 1u == (gen + 1u) * nloc) {
            __builtin_amdgcn_fence(__ATOMIC_RELEASE, "agent");
            asm volatile("s_waitcnt vmcnt(0)" ::: "memory");
            const unsigned og = xb_add(&bar[XB_TOP], 1u);
            const unsigned tg = og / nx;
            if (og + 1u == (tg + 1u) * nx) xb_add(&bar[XB_TOPGEN], 1u);
            else XB_SPIN(xb_ld(&bar[XB_TOPGEN]) == tg, bar);
            __builtin_amdgcn_fence(__ATOMIC_ACQUIRE, "agent");
            xb_add(&bar[XB_XGEN(b.x)], 1u);
            asm volatile("s_waitcnt vmcnt(0)" ::: "memory");
        } else {
            XB_SPIN(xb_ld(&bar[XB_XGEN(b.x)]) == gen, bar);
            __builtin_amdgcn_fence(__ATOMIC_ACQUIRE, "agent");
            asm volatile("s_waitcnt vmcnt(0)" ::: "memory");
        }
    }
    __syncthreads();
}

struct Args { const float* in[20]; float* out; unsigned char* ws; int ph_lo, ph_hi; };
#define WSP(T, off) ((T*)(C.a->ws + (off)))
struct Ctx {
    LAS unsigned char* lds;
    int tid, wave, gw, ngw;
    __device__ __forceinline__ int ln() const { int t = threadIdx.x; asm volatile("" : "+v"(t)); return t & 63; }
    const Args* a;
    __device__ __forceinline__ const float* in(int i) const { return a->in[i]; }
    __device__ __forceinline__ float* out() const { return a->out; }
    __device__ __forceinline__ unsigned* ctl() const { return (unsigned*)(a->ws + WS_CTL); }
    __device__ __forceinline__ float* SSQ() const { return (float*)(a->ws + WS_CTL) + CW_SSQ; }
};
enum { I_X = 0, I_META, I_N1G, I_WIN, I_BGATE, I_KVG, I_WUK, I_WUV, I_WPA, I_WPB, I_WOUT, I_N2G, I_WRG, I_BRG, I_WRE, I_BRE, I_W1, I_W3, I_W2, I_FG };

__device__ __forceinline__ int win_src(int n) {
    if (n < C_QN) return n;
    if (n < C_QR) { const int t = n - C_QN; return 3072 + (t >> 7) * 192 + (t & 127); }
    if (n < C_CKV) { const int t = n - C_QR, h = t >> 6, p = t & 63; return 3072 + h * 192 + 128 + (p & 1) * 32 + (p >> 1); }
    if (n < C_GATE) return n;
    if (n < C_KR) return n + 64;
    if (n < C_END) { const int p = n - C_KR; return 6656 + (p & 1) * 32 + (p >> 1); }
    return -1;
}
struct SrcWin { const float* W; __device__ __forceinline__ float get(int k, int n) const { const int s = win_src(n); return s < 0 ? 0.f : W[(size_t)k * 10816 + s]; } };
struct SrcKV { const float *uk, *uv, *g; __device__ __forceinline__ float get(int k, int n) const { return (n < 2048 ? uk[(size_t)k * 2048 + n] : uv[(size_t)k * 2048 + n - 2048]) * g[k]; } };
struct SrcPlain { const float* W; int N; __device__ __forceinline__ float get(int k, int n) const { return W[(size_t)k * N + n]; } };
struct SrcW13 { const float *w1, *w3, *g; __device__ __forceinline__ float get(int k, int n) const { const int f = 4 * (n >> 3) + (n & 3); const long long d = (n & 4) ? ((const char*)w3 - (const char*)w1) : 0ll;
        return *(const float*)((const char*)(w1 + (size_t)k * FF + f) + d) * g[k]; } };

template <class Src>
__device__ __forceinline__ void tr_matrix(const Src& S, int K, int N, bf16* WT, size_t ldd, LAS float* scr, int gw, int ngw, int lane) {
    const int nblk = N / 32, nitems = (K / 64) * nblk;
    for (int it = gw; it < nitems; it += ngw) {
        const int kb = it / nblk, nb = it % nblk, k0 = 64 * kb, n0 = 32 * nb;
#pragma unroll 8
        for (int i = 0; i < 32; ++i) { const int kk = 2 * i + (lane >> 5); scr[kk * 33 + (lane & 31)] = S.get(k0 + kk, n0 + (lane & 31)); }
        LDS_WAIT(); asm volatile("" ::: "memory");
        const int c = lane & 7;
#pragma unroll
        for (int j = 0; j < 4; ++j) { const int n = (lane >> 3) + 8 * j; const LAS float* s = scr + (8 * c) * 33 + n;
            u32x4 o; o.x = cvt_pk_bf16(s[0 * 33], s[1 * 33]); o.y = cvt_pk_bf16(s[2 * 33], s[3 * 33]); o.z = cvt_pk_bf16(s[4 * 33], s[5 * 33]); o.w = cvt_pk_bf16(s[6 * 33], s[7 * 33]);
            *(u32x4*)(WT + (size_t)(n0 + n) * ldd + k0 + 8 * c) = o; }
        LDS_WAIT(); asm volatile("" ::: "memory");
    }
}
__device__ __forceinline__ void rms_row_to_bf16(const float* xrow, const float* g, bf16* orow, int lane) {
    const f32x4* xr = (const f32x4*)xrow + lane; const f32x4* gr = (const f32x4*)g + lane;
    f32x4 v[8]; float s = 0.f;
#pragma unroll
    for (int j = 0; j < 8; ++j) { v[j] = xr[64 * j]; s += (v[j].x * v[j].x + v[j].y * v[j].y) + (v[j].z * v[j].z + v[j].w * v[j].w); }
    const float rstd = 1.f / sqrtf(wave_sum(s) * (1.f / DM) + RMS_EPS);
    u32x2* o8 = (u32x2*)orow + lane;
#pragma unroll
    for (int j = 0; j < 8; ++j) { const f32x4 gg = gr[64 * j]; u32x2 w; w.x = cvt_pk_bf16(v[j].x * rstd * gg.x, v[j].y * rstd * gg.y); w.y = cvt_pk_bf16(v[j].z * rstd * gg.z, v[j].w * rstd * gg.w); o8[64 * j] = w; }
}
__device__ __forceinline__ int win_dst(int s) {
    if (s < 3072) return s;
    if (s < 6144) { const int t = s - 3072, h = t / 192, d = t - h * 192; if (d < 128) return C_QN + h * 128 + d; const int j = d - 128; return C_QR + h * 64 + 2 * (j & 31) + (j >> 5); }
    if (s < 6656) return s;
    if (s < 6720) { const int j = s - 6656; return C_KR + 2 * (j & 31) + (j >> 5); }
    return s - 64;
}
__device__ __forceinline__ int tr_dst(int kind, int roff, int s) { return kind == 1 ? win_dst(s) : kind == 2 ? 8 * (s >> 2) + (s & 3) + roff : s + roff; }
__device__ __forceinline__ void tr_unit(const float* W, int N, const float* g, bf16* WT, int ldd, int kind, int roff, int sblk, int k0, int lane, LAS float* scr, int sub_lo = 0, int sub_hi = 8) {
    const int kq = lane >> 3, n4 = lane & 7, c = lane & 7;
    for (int sub = sub_lo; sub < sub_hi; ++sub) {
        const int s0 = sblk * 256 + sub * 32;
        if (s0 >= N) break;
        const float* wp = W + (size_t)(k0 + kq) * N + s0 + 4 * n4;
        f32x4 v[8];
#pragma unroll
        for (int i = 0; i < 8; ++i) v[i] = *(const f32x4*)(wp + (size_t)(8 * i) * N);
        if (g) {
#pragma unroll
            for (int i = 0; i < 8; ++i) v[i] = v[i] * g[k0 + kq + 8 * i];
        }
#pragma unroll
        for (int i = 0; i < 8; ++i) *(LAS f32x4*)(scr + (kq + 8 * i) * 32 + ((4 * n4) ^ (4 * i))) = v[i];
        LDS_WAIT(); asm volatile("" ::: "memory");
#pragma unroll
        for (int j = 0; j < 4; ++j) { const int si = (lane >> 3) + 8 * j; const LAS float* p = scr + (8 * c) * 32 + (si ^ (4 * c));
            u32x4 o; o.x = cvt_pk_bf16(p[0 * 32], p[1 * 32]); o.y = cvt_pk_bf16(p[2 * 32], p[3 * 32]); o.z = cvt_pk_bf16(p[4 * 32], p[5 * 32]); o.w = cvt_pk_bf16(p[6 * 32], p[7 * 32]);
            *(u32x4*)(WT + (size_t)tr_dst(kind, roff, s0 + si) * ldd + k0 + 8 * c) = o; }
        LDS_WAIT(); asm volatile("" ::: "memory");
    }
}
constexpr int U_WIN = 43 * 32, U_UK = 8 * 8, U_PA = 8 * 16, U_PB = 8 * 32, U_OUT = 8 * 32, U_W1 = NE * 4 * 32, U_W2 = NE * 8 * 16;
constexpr int UO_UK = U_WIN, UO_UV = UO_UK + U_UK, UO_PA = UO_UV + U_UK, UO_PB = UO_PA + U_PA, UO_OUT = UO_PB + U_PB, UO_W1 = UO_OUT + U_OUT, UO_W3 = UO_W1 + U_W1, UO_W2 = UO_W3 + U_W1, U_TOTAL = UO_W2 + U_W2;
__device__ __forceinline__ void tr_dispatch(const Ctx& C, int u, int lane, LAS float* scr, int sub_lo = 0, int sub_hi = 8) {
    if (u < UO_UK) { tr_unit(C.in(I_WIN), 10816, nullptr, WSP(bf16, WS_WIN), 2048, 1, 0, u >> 5, (u & 31) * 64, lane, scr, sub_lo, sub_hi); return; }
    if (u < UO_UV) { const int t = u - UO_UK; tr_unit(C.in(I_WUK), 2048, C.in(I_KVG), WSP(bf16, WS_WKV), 512, 0, 0, t >> 3, (t & 7) * 64, lane, scr, sub_lo, sub_hi); return; }
    if (u < UO_PA) { const int t = u - UO_UV; tr_unit(C.in(I_WUV), 2048, C.in(I_KVG), WSP(bf16, WS_WKV), 512, 0, 2048, t >> 3, (t & 7) * 64, lane, scr, sub_lo, sub_hi); return; }
    if (u < UO_PB) { const int t = u - UO_PA; tr_unit(C.in(I_WPA), 2048, nullptr, WSP(bf16, WS_WPROJ), 3072, 0, 0, t >> 4, (t & 15) * 64, lane, scr, sub_lo, sub_hi); return; }
    if (u < UO_OUT) { const int t = u - UO_PB; tr_unit(C.in(I_WPB), 2048, nullptr, WSP(bf16, WS_WPROJ) + 1024, 3072, 0, 0, t >> 5, (t & 31) * 64, lane, scr, sub_lo, sub_hi); return; }
    if (u < UO_W1) { const int t = u - UO_OUT; tr_unit(C.in(I_WOUT), 2048, nullptr, WSP(bf16, WS_WOUT), 2048, 0, 0, t >> 5, (t & 31) * 64, lane, scr, sub_lo, sub_hi); return; }
    if (u < UO_W3) { const int t = u - UO_W1, e = t >> 7, r = t & 127; tr_unit(C.in(I_W1) + (size_t)e * 2048 * FF, FF, C.in(I_N2G), WSP(bf16, WS_W13) + (size_t)e * 2048 * 2048, 2048, 2, 0, r >> 5, (r & 31) * 64, lane, scr, sub_lo, sub_hi); return; }
    if (u < UO_W2) { const int t = u - UO_W3, e = t >> 7, r = t & 127; tr_unit(C.in(I_W3) + (size_t)e * 2048 * FF, FF, C.in(I_N2G), WSP(bf16, WS_W13) + (size_t)e * 2048 * 2048, 2048, 2, 4, r >> 5, (r & 31) * 64, lane, scr, sub_lo, sub_hi); return; }
    { const int t = u - UO_W2, e = t >> 7, r = t & 127; tr_unit(C.in(I_W2) + (size_t)e * FF * 2048, 2048, nullptr, WSP(bf16, WS_W2) + (size_t)e * 2048 * FF, FF, 0, 0, r >> 4, (r & 15) * 64, lane, scr, sub_lo, sub_hi); }
}
constexpr int BG_UNITS = U_TOTAL - UO_W1;
constexpr int BGL_OFF = LDSCTL_OFF + 1024;
__device__ __forceinline__ void bg_reset(const Ctx& C) { LAS int* st = (LAS int*)(C.lds + BGL_OFF); if (C.tid < 8) { st[2 * C.tid] = -1; st[2 * C.tid + 1] = 8; } }
__device__ __forceinline__ bool bg_step(const Ctx& C) {
    LAS int* st = (LAS int*)(C.lds + BGL_OFF) + 2 * C.wave; LAS float* scr = (LAS float*)(C.lds + C.wave * 8192);
    int u = st[0], sub = st[1];
    if (sub >= 8) {
        if (u == -2) return false;
        int nu = 0; if (C.ln() == 0) nu = (int)__hip_atomic_fetch_add(C.ctl() + CW_BGQ, 1u, __ATOMIC_RELAXED, __HIP_MEMORY_SCOPE_AGENT);
        nu = __builtin_amdgcn_readfirstlane(nu);
        if (nu >= BG_UNITS) { if (C.ln() == 0) { st[0] = -2; st[1] = 8; } return false; }
        u = nu; sub = 0;
    }
    tr_dispatch(C, UO_W1 + u, C.ln(), scr, sub, sub + 1);
    if (C.ln() == 0) { st[0] = u; st[1] = sub + 1; }
    return true;
}
__device__ __forceinline__ void p0_prologue(Ctx& C) {
    const int gw = C.gw, ngw = C.ngw, lane = C.ln();
    {
        LAS int* qc = (LAS int*)(C.lds + 8 * 8192); LAS float* scr = (LAS float*)(C.lds + C.wave * 8192);
        if (C.tid == 0) qc[0] = 0;
        __syncthreads();
        const int G = gridDim.x, ub = (int)(((long)UO_W1 * blockIdx.x) / G), ue = (int)(((long)UO_W1 * (blockIdx.x + 1)) / G);
        for (;;) {
            int u = 0; if (lane == 0) u = __hip_atomic_fetch_add(qc, 1, __ATOMIC_RELAXED, __HIP_MEMORY_SCOPE_WORKGROUP);
            u = __builtin_amdgcn_readfirstlane(u) + ub;
            if (u >= ue) break;
            tr_dispatch(C, u, lane, scr);
        }
    }
    for (int i = gw * 64 + lane; i < (NIN - C_END) * 2048 / 8; i += ngw * 64) { const u32x4 z = {0u, 0u, 0u, 0u}; ((u32x4*)(WSP(bf16, WS_WIN) + (size_t)C_END * 2048))[i] = z; }
    for (int m = gw; m < MR; m += ngw) {
        if (m < M) rms_row_to_bf16(C.in(I_X) + (size_t)m * DM, C.in(I_N1G), WSP(bf16, WS_HN) + (size_t)m * DM, lane);
        else if (m < M + NMETA) rms_row_to_bf16(C.in(I_META) + (size_t)(m - M) * DM, C.in(I_N1G), WSP(bf16, WS_HN) + (size_t)m * DM, lane);
        else { u32x4* o = (u32x4*)(WSP(bf16, WS_HN) + (size_t)m * DM) + lane; const u32x4 z = {0u, 0u, 0u, 0u};
#pragma unroll
            for (int j = 0; j < 4; ++j) o[64 * j] = z; }
    }
    for (int i = gw * 64 + lane; i < (SEQ + NMETA) * 32; i += ngw * 64) {
        const int pos = i >> 5, j = i & 31;
        double inv = 1.0; for (int q = 0; q < j; ++q) inv *= 0.7498942093324559;
        const double rev = (double)pos * inv * 0.15915494309189535;
        const double t = (rev - floor(rev + 0.5)) * 6.283185307179586, t2 = t * t;
        double ps = 1.0, pc = 1.0;
#pragma unroll
        for (int k = 13; k >= 1; --k) { ps = 1.0 - ps * t2 * (1.0 / (double)((2 * k) * (2 * k + 1))); pc = 1.0 - pc * t2 * (1.0 / (double)((2 * k - 1) * (2 * k))); }
        f32x2 cs; cs.x = (float)pc; cs.y = (float)(t * ps); WSP(f32x2, WS_ROPE)[i] = cs;
    }
    for (int i = gw * 64 + lane; i < 48 * DM; i += ngw * 64) {
        const int j = i >> 11, k = i & 2047;
        float w = 0.f;
        if (j < 4) w = C.in(I_WRG)[k * 4 + j] * C.in(I_N2G)[k]; else if (j < 36) w = C.in(I_WRE)[k * 32 + (j - 4)] * C.in(I_N2G)[k];
        WSP(float, WS_WR)[i] = w;
    }
}

__device__ __forceinline__ void xcd_barrier_bg(const XcdBarrier& b, const Ctx& C) {
    asm volatile("s_waitcnt vmcnt(0)" ::: "memory");
    __syncthreads();
    volatile LAS int* flg = (volatile LAS int*)(C.lds + BGL_OFF + 64);
    if (threadIdx.x == 0) {
        unsigned* bar = b.bar;
        __builtin_amdgcn_s_waitcnt(0);
        unsigned nloc = b.st[0], nx = b.st[1];
        if (nloc == 0u) { xcd_barrier_complete(bar, b.x, nloc, nx); b.st[0] = nloc; b.st[1] = nx; }
        const unsigned old = xb_add(&bar[XB_XSUB(b.x)], 1u);
        const unsigned gen = old / nloc;
        if (old + 1u == (gen + 1u) * nloc) {
            __builtin_amdgcn_fence(__ATOMIC_RELEASE, "agent");
            asm volatile("s_waitcnt vmcnt(0)" ::: "memory");
            const unsigned og = xb_add(&bar[XB_TOP], 1u);
            const unsigned tg = og / nx;
            if (og + 1u == (tg + 1u) * nx) xb_add(&bar[XB_TOPGEN], 1u);
            else XB_SPIN(xb_ld(&bar[XB_TOPGEN]) == tg, bar);
            __builtin_amdgcn_fence(__ATOMIC_ACQUIRE, "agent");
            xb_add(&bar[XB_XGEN(b.x)], 1u);
            asm volatile("s_waitcnt vmcnt(0)" ::: "memory");
            flg[0] = 0;
        } else { flg[0] = 1; flg[1] = 0; flg[2] = (int)gen; }
    }
    __syncthreads();
    if (flg[0] == 1) {
        unsigned spins = 0; const unsigned gen = (unsigned)flg[2];
        for (;;) {
            if (C.wave == 0 && C.ln() == 0) { if (xb_ld(&b.bar[XB_XGEN(b.x)]) != gen || xb_ld(&b.bar[XB_TMO]) != 0u) flg[1] = 1; else if (++spins > XB_SPIN_CAP) { atomicAdd(&b.bar[XB_TMO], 1u); flg[1] = 1; } }
            if (flg[1] != 0) break;
            if (!bg_step(C)) __builtin_amdgcn_s_sleep(8);
        }
        __syncthreads();
        if (threadIdx.x == 0) { __builtin_amdgcn_fence(__ATOMIC_ACQUIRE, "agent"); asm volatile("s_waitcnt vmcnt(0)" ::: "memory"); }
    }
    __syncthreads();
}

__device__ __forceinline__ void st8_bf16(bf16* p, const float (&v)[8]) { u32x4 w; w.x = cvt_pk_bf16(v[0], v[1]); w.y = cvt_pk_bf16(v[2], v[3]); w.z = cvt_pk_bf16(v[4], v[5]); w.w = cvt_pk_bf16(v[6], v[7]); *(u32x4*)p = w; }
__device__ __forceinline__ float sigmoidf_(float x) { return __builtin_amdgcn_rcpf(1.f + __builtin_amdgcn_exp2f(-LOG2E * x)); }
__device__ __forceinline__ size_t blk_off(int row, int col, int nc) { return ((size_t)(row >> 4) * (nc >> 5) + (col >> 5)) * 512 + (row & 15) * 32 + (col & 31); }
struct EpiIn {
    bf16 *QCAT, *SBK, *SBV, *QR, *CKV, *GATE, *KR; const float* b_gate; const f32x2* rope; float* SSQP;
    static constexpr bool HAS_MID = false;
    struct ColPre { f32x4 b0, b1; }; struct RowPre { f32x4 t0, t1; };
    __device__ __forceinline__ int kind(int ocol) const { return ocol < C_SBK ? 0 : ocol < C_SBV ? 1 : ocol < C_QN ? 2 : ocol < C_QR ? 3 : ocol < C_CKV ? 4 : ocol < C_GATE ? 5 : ocol < C_KR ? 6 : 7; }
    __device__ __forceinline__ void col_pre(int kind, int col, ColPre& c) const { if (kind == 6) { c.b0 = *(const f32x4*)(b_gate + (col - C_GATE)); c.b1 = *(const f32x4*)(b_gate + (col - C_GATE) + 4); } }
    __device__ __forceinline__ void row_pre(int kind, int row, int col, RowPre& r) const {
        if (kind == 4 || kind == 7) { const int pos = row < M ? NMETA + (row & (SEQ - 1)) : (row - M); const int j0 = kind == 4 ? (((col - C_QR) & 63) >> 1) : ((col - C_KR) >> 1);
            const f32x4* t = (const f32x4*)(rope + (size_t)pos * 32 + (j0 & 31)); r.t0 = t[0]; r.t1 = t[1]; }
    }
    __device__ __forceinline__ void mid8(int, int, int, float (&)[8], const RowPre&) const {}
    __device__ __forceinline__ void rope8(float (&v)[8], const RowPre& r, float sc) const {
        const float c[4] = {r.t0.x, r.t0.z, r.t1.x, r.t1.z}, sn[4] = {r.t0.y, r.t0.w, r.t1.y, r.t1.w};
#pragma unroll
        for (int q = 0; q < 4; ++q) { const float x1 = v[2 * q], x2 = v[2 * q + 1]; v[2 * q] = (x1 * c[q] - x2 * sn[q]) * sc; v[2 * q + 1] = (x1 * sn[q] + x2 * c[q]) * sc; }
    }
    __device__ __forceinline__ void store8(int kind, int row, int col, float (&v)[8], const ColPre& c, const RowPre& r) const {
        if (kind == 0) {
#pragma unroll
            for (int i = 0; i < 8; ++i) v[i] *= SB_QS;
            st8_bf16(QCAT + (size_t)row * 3072 + col, v);
        } else if (kind == 1) st8_bf16(SBK + (size_t)row * 1024 + (col - C_SBK), v);
        else if (kind == 2) st8_bf16(SBV + (size_t)row * 1024 + (col - C_SBV), v);
        else if (kind == 3) {
#pragma unroll
            for (int i = 0; i < 8; ++i) v[i] *= MLA_QS;
            st8_bf16(QCAT + (size_t)row * 3072 + 1024 + (col - C_QN), v);
        } else if (kind == 4) { rope8(v, r, MLA_QS); st8_bf16(QR + (size_t)row * 1024 + (col - C_QR), v); }
        else if (kind == 5) {
            float ss = 0.f;
#pragma unroll
            for (int i = 0; i < 8; ++i) ss += v[i] * v[i];
            ss += __shfl_xor(ss, 16); ss += __shfl_xor(ss, 32);
            const int cc = col - C_CKV;
            if ((threadIdx.x & 48) == 0) SSQP[(size_t)row * 16 + ((cc >> 8) << 3) + (((cc >> 5) & 3) << 1) + ((cc >> 7) & 1)] = ss;
            st8_bf16(CKV + (size_t)row * 512 + cc, v);
        }
        else if (kind == 6) {
            v[0] = sigmoidf_(v[0] + c.b0.x); v[1] = sigmoidf_(v[1] + c.b0.y); v[2] = sigmoidf_(v[2] + c.b0.z); v[3] = sigmoidf_(v[3] + c.b0.w);
            v[4] = sigmoidf_(v[4] + c.b1.x); v[5] = sigmoidf_(v[5] + c.b1.y); v[6] = sigmoidf_(v[6] + c.b1.z); v[7] = sigmoidf_(v[7] + c.b1.w);
            st8_bf16(GATE + blk_off(row, col - C_GATE, 4096), v);
        } else if (col < C_END) { rope8(v, r, 1.f); st8_bf16(KR + (size_t)row * 64 + (col - C_KR), v); }
    }
};
__device__ __forceinline__ void kv_meta_unit(const Ctx& C, int mu) {
    const int lane = C.ln(), r = lane & 15, q = lane >> 4;
    const bf16* A = WSP(bf16, WS_CKV) + (size_t)(M + r) * 512 + q * 8;
    const bf16* B = WSP(bf16, WS_WKV) + (size_t)(16 * mu + r) * 512 + q * 8;
    f32x4 acc = {0.f, 0.f, 0.f, 0.f};
#pragma unroll
    for (int s = 0; s < 16; ++s) acc = __builtin_amdgcn_mfma_f32_16x16x32_bf16(*(const bf16x8*)(A + 32 * s), *(const bf16x8*)(B + 32 * s), acc, 0, 0, 0);
    const int col = 16 * mu + r;
    bf16* dst = col < 2048 ? WSP(bf16, WS_KN) + col : WSP(bf16, WS_VV) + (col - 2048);
#pragma unroll
    for (int i = 0; i < 4; ++i) {
        const int row = M + 4 * q + i; const f32x4* p = (const f32x4*)(WSP(float, WS_SSQP) + (size_t)row * 16);
        const f32x4 qq = (p[0] + p[1]) + (p[2] + p[3]); const float rstd = 1.f / sqrtf(((qq.x + qq.y) + (qq.z + qq.w)) * (1.f / 512.f) + RMS_EPS);
        ((unsigned short*)dst)[(size_t)row * 2048] = (unsigned short)(cvt_pk_bf16(acc[i] * rstd, 0.f) & 0xffffu);
    }
    if (lane < 48) { bf16* z = (16 * mu < 2048 ? WSP(bf16, WS_KN) + 16 * mu : WSP(bf16, WS_VV) + (16 * mu - 2048)) + (size_t)(M + 16 + lane) * 2048;
        const u32x4 zz = {0u, 0u, 0u, 0u}; ((u32x4*)z)[0] = zz; ((u32x4*)z)[1] = zz; }
}
struct EpiKV {
    bf16 *KN, *VV; const float* SSQP; LAS float* rl;
    static constexpr bool HAS_MID = false; static constexpr bool HAS_UNIT_PRE = true;
    struct ColPre {}; struct RowPre { float rstd; };
    __device__ __forceinline__ int kind(int ocol) const { return ocol < 2048 ? 0 : 1; }
    __device__ __forceinline__ void col_pre(int, int, ColPre&) const {}
    __device__ __forceinline__ void row_pre(int, int trow, int, RowPre& r) const { r.rstd = rl[trow]; }
    __device__ __forceinline__ void mid8(int, int, int, float (&)[8], const RowPre&) const {}
    __device__ __forceinline__ void store8(int kind, int row, int col, float (&v)[8], const ColPre&, const RowPre& r) const {
        const float rstd = r.rstd;
#pragma unroll
        for (int i = 0; i < 8; ++i) v[i] *= rstd;
        if (kind == 0) st8_bf16(KN + (size_t)row * 2048 + col, v); else st8_bf16(VV + (size_t)row * 2048 + (col - 2048), v);
    }
};
struct EpiProj {
    const bf16* GATE; bf16* Y;
    static constexpr bool HAS_MID = true;
    struct ColPre {}; struct RowPre { u32x4 a, b; };
    __device__ __forceinline__ int kind(int) const { return 0; }
    __device__ __forceinline__ void col_pre(int, int, ColPre&) const {}
    __device__ __forceinline__ void row_pre(int kind, int row, int col, RowPre& r) const {
        r.b = *(const u32x4*)(GATE + blk_off(row, 2048 + col, 4096)); if (kind == 1) r.a = *(const u32x4*)(GATE + blk_off(row, col, 4096));
    }
    __device__ __forceinline__ void mid8(int, int, int, float (&v)[8], const RowPre& r) const {
        const unsigned aw[4] = {r.a.x, r.a.y, r.a.z, r.a.w}, bw[4] = {r.b.x, r.b.y, r.b.z, r.b.w};
#pragma unroll
        for (int q = 0; q < 4; ++q) { v[2 * q] *= bflo(aw[q]) * __builtin_amdgcn_rcpf(fmaxf(bflo(bw[q]), 1e-30f)); v[2 * q + 1] *= bfhi(aw[q]) * __builtin_amdgcn_rcpf(fmaxf(bfhi(bw[q]), 1e-30f)); }
    }
    __device__ __forceinline__ void store8(int, int row, int col, float (&v)[8], const ColPre&, const RowPre& r) const {
        const unsigned bw[4] = {r.b.x, r.b.y, r.b.z, r.b.w};
#pragma unroll
        for (int q = 0; q < 4; ++q) { v[2 * q] *= fmaxf(bflo(bw[q]), 1e-30f); v[2 * q + 1] *= fmaxf(bfhi(bw[q]), 1e-30f); }
        st8_bf16(Y + (size_t)row * 2048 + col, v);
    }
};
struct EpiOut {
    const float* x; float* H1; bf16* H1B;
    static constexpr bool HAS_MID = false;
    struct ColPre {}; struct RowPre { f32x4 x0, x1; };
    __device__ __forceinline__ int kind(int) const { return 0; }
    __device__ __forceinline__ void col_pre(int, int, ColPre&) const {}
    __device__ __forceinline__ void row_pre(int, int row, int col, RowPre& r) const { r.x0 = *(const f32x4*)(x + (size_t)row * DM + col); r.x1 = *(const f32x4*)(x + (size_t)row * DM + col + 4); }
    __device__ __forceinline__ void mid8(int, int, int, float (&)[8], const RowPre&) const {}
    __device__ __forceinline__ void store8(int, int row, int col, float (&v)[8], const ColPre&, const RowPre& r) const {
        f32x4 o0 = {v[0] + r.x0.x, v[1] + r.x0.y, v[2] + r.x0.z, v[3] + r.x0.w}, o1 = {v[4] + r.x1.x, v[5] + r.x1.y, v[6] + r.x1.z, v[7] + r.x1.w};
        *(f32x4*)(H1 + (size_t)row * DM + col) = o0; *(f32x4*)(H1 + (size_t)row * DM + col + 4) = o1;
        float w8[8] = {o0.x, o0.y, o0.z, o0.w, o1.x, o1.y, o1.z, o1.w}; st8_bf16(H1B + (size_t)row * DM + col, w8);
    }
};
struct EpiUp {
    bf16* HID; const float* RSS; LAS float* rl;
    static constexpr bool HAS_MID = false;
    struct ColPre {}; struct RowPre { float rs; };
    __device__ __forceinline__ int kind(int) const { return 0; }
    __device__ __forceinline__ void col_pre(int, int, ColPre&) const {}
    __device__ __forceinline__ void row_pre(int, int trow, int, RowPre& r) const { r.rs = rl[trow]; }
    __device__ __forceinline__ void mid8(int, int, int, float (&)[8], const RowPre&) const {}
    __device__ __forceinline__ void store8(int, int row, int col, float (&v)[8], const ColPre&, const RowPre& r) const {
        float h[4];
#pragma unroll
        for (int i = 0; i < 4; ++i) { const float a1 = v[i] * r.rs, a3 = v[4 + i] * r.rs; h[i] = a1 * sigmoidf_(a1) * a3; }
        u32x2 w; w.x = cvt_pk_bf16(h[0], h[1]); w.y = cvt_pk_bf16(h[2], h[3]);
        *(u32x2*)(HID + (size_t)row * FF + (col >> 1)) = w;
    }
};
struct EpiDown {
    bf16* YS;
    static constexpr bool HAS_MID = false;
    struct ColPre {}; struct RowPre {};
    __device__ __forceinline__ int kind(int) const { return 0; }
    __device__ __forceinline__ void col_pre(int, int, ColPre&) const {}
    __device__ __forceinline__ void row_pre(int, int, int, RowPre&) const {}
    __device__ __forceinline__ void mid8(int, int, int, float (&)[8], const RowPre&) const {}
    __device__ __forceinline__ void store8(int, int row, int col, float (&v)[8], const ColPre&, const RowPre&) const { st8_bf16(YS + (size_t)row * 2048 + col, v); }
};
__device__ __forceinline__ int perm32(int rho) { const int n = rho >> 4, i = rho & 15; return 8 * (i >> 2) + 4 * n + (i & 3); }

namespace pg8 {
constexpr int BM = 256, BK = 64, HALF = 128, HTB = HALF * BK * 2, STAGE_BYTES = 8 * HTB, NXCD = 8, WGM = 8;
__device__ __forceinline__ int lds_byte(int r, int c) { const int st = (r >> 4) * 2 + (c >> 5), rr = r & 15, cc = c & 31, ob = rr * 64 + cc * 2; return st * 1024 + (ob ^ (((ob >> 9) & 1) << 5)); }
__device__ __forceinline__ void stage_rc(int b, int& R, int& C) { const int st = b / 1024, sb = b % 1024, swz = sb ^ (((sb >> 9) & 1) << 5); R = (st >> 1) * 16 + swz / 64; C = (st & 1) * 32 + (swz % 64) / 2; }
struct Unit { int arow, brow, orow, ocol, idx; };
struct Gemm { const bf16* A; const bf16* Bt; int lda, ldb, K, mid_t; };
__device__ __forceinline__ bool tile_of(int i, int G, int c, int nM, int nN, int& pm, int& pn) {
    const int nwg = nM * nN; const long L = (long)i * G + c; if (L >= nwg) return false;
    int wgid = (int)L; { const int q = nwg / NXCD, r = nwg % NXCD, xcd = wgid % NXCD, off = wgid / NXCD; wgid = (xcd < r ? xcd * (q + 1) : r * (q + 1) + (xcd - r) * q) + off; }
    const int nig = WGM * nN, gid = wgid / nig, fm = gid * WGM, gsz = (nM - fm) < WGM ? (nM - fm) : WGM;
    pm = fm + ((wgid % nig) % gsz); pn = (wgid % nig) / gsz; return true;
}
struct DenseOrder { static constexpr bool GATHER = false; int nM, nN, G, c;
    __device__ __forceinline__ bool next(int i, Unit& u) const { int pm, pn; if (!tile_of(i, G, c, nM, nN, pm, pn)) return false; u.arow = pm * BM; u.brow = pn * BM; u.orow = pm * BM; u.ocol = pn * BM; u.idx = i; return true; } };
struct GroupOrder { static constexpr bool GATHER = false; int nT, G, c; const LAS int* tt; int maxi;
    __device__ __forceinline__ bool next(int i, Unit& u) const {
        const int nwg = nT * 8; const long L = (long)i * G + c; if (i >= maxi || L >= nwg) return false;
        int wgid = (int)L; { const int q = nwg / NXCD, r = nwg % NXCD, xcd = wgid % NXCD, off = wgid / NXCD; wgid = (xcd < r ? xcd * (q + 1) : r * (q + 1) + (xcd - r) * q) + off; }
        const int t = wgid >> 3, cn = wgid & 7; const int e = __builtin_amdgcn_readfirstlane(tt[t]);
        u.arow = t * BM; u.brow = e * 2048 + cn * BM; u.orow = t * BM; u.ocol = cn * BM; u.idx = i; return true; } };
struct HalfOrder { static constexpr bool GATHER = false; int nT, G, c, R; const LAS int* tt;
    __device__ __forceinline__ bool next(int i, Unit& u) const {
        const int nwg = nT * 8; const long L = (long)R * G + (c >> 1); if (i > 0 || L >= nwg) return false;
        int wgid = (int)L; { const int q = nwg / NXCD, r = nwg % NXCD, xcd = wgid % NXCD, off = wgid / NXCD; wgid = (xcd < r ? xcd * (q + 1) : r * (q + 1) + (xcd - r) * q) + off; }
        const int t = wgid >> 3, cn = wgid & 7; const int e = __builtin_amdgcn_readfirstlane(tt[t]);
        u.arow = t * BM; u.brow = e * 2048 + cn * BM + (c & 1) * HALF; u.orow = t * BM; u.ocol = cn * BM + (c & 1) * HALF; u.idx = 8; return true; } };
template <class O> struct GatherOf { static constexpr bool GATHER = true; O o; const LAS int* stok;
    __device__ __forceinline__ bool next(int i, Unit& u) const { return o.next(i, u); } };
struct GatherOrder { static constexpr bool GATHER = true; GroupOrder o; const LAS int* stok;
    __device__ __forceinline__ bool next(int i, Unit& u) const { return o.next(i, u); } };
#define PIPE_EPI_OF(F) (__is_same(F, EpiProj) || __is_same(F, EpiOut))
template <class F> struct EpiW {
    F f; static constexpr bool HAS_MID = F::HAS_MID;
    template <bool HN = false> __device__ __forceinline__ void run(f32x4 (&acc)[2][2][4][2], const Unit& u, int wr, int wc, int fr, int fq) const {
        constexpr int NBJ = HN ? 1 : 2;
        constexpr bool TAB = __is_same(F, EpiKV) || __is_same(F, EpiUp);
        const int rbase = TAB ? u.idx * 256 - u.orow : 0;
        const int row0 = u.orow + wr * 64 + fr, col0 = u.ocol + wc * 32 + 8 * fq;
        const int kind = __builtin_amdgcn_readfirstlane(f.kind(u.ocol));
        typename F::ColPre cp[2];
#pragma unroll
        for (int bj = 0; bj < NBJ; ++bj) f.col_pre(kind, col0 + bj * HALF, cp[bj]);
        constexpr bool PIPE = PIPE_EPI_OF(F);
        typename F::RowPre rp[2][2][2];
        if constexpr (PIPE) {
#pragma unroll
        for (int mm = 0; mm < 2; ++mm)
#pragma unroll
            for (int bj = 0; bj < NBJ; ++bj) f.row_pre(kind, rbase + row0 + mm * 16, col0 + bj * HALF, rp[0][mm][bj]); }
#pragma unroll
        for (int b = 0; b < 4; ++b) {
            const int ai = b >> 1, mp = (b & 1) * 2;
            if constexpr (!PIPE) {
#pragma unroll
                for (int mm = 0; mm < 2; ++mm)
#pragma unroll
                    for (int bj = 0; bj < NBJ; ++bj) f.row_pre(kind, rbase + row0 + ai * HALF + (mp + mm) * 16, col0 + bj * HALF, rp[b & 1][mm][bj]); }
            if (PIPE && b + 1 < 4) { const int ai2 = (b + 1) >> 1, mp2 = ((b + 1) & 1) * 2;
#pragma unroll
                for (int mm = 0; mm < 2; ++mm)
#pragma unroll
                    for (int bj = 0; bj < NBJ; ++bj) f.row_pre(kind, rbase + row0 + ai2 * HALF + (mp2 + mm) * 16, col0 + bj * HALF, rp[(b + 1) & 1][mm][bj]); }
#pragma unroll
            for (int mm = 0; mm < 2; ++mm)
#pragma unroll
                for (int bj = 0; bj < NBJ; ++bj) { const int m = mp + mm; const f32x4 a = acc[ai][bj][m][0], bb = acc[ai][bj][m][1]; float v[8] = {a[0], a[1], a[2], a[3], bb[0], bb[1], bb[2], bb[3]};
                    f.store8(kind, row0 + ai * HALF + m * 16, col0 + bj * HALF, v, cp[bj], rp[b & 1][mm][bj]);
                    acc[ai][bj][m][0] = (f32x4){0.f, 0.f, 0.f, 0.f}; acc[ai][bj][m][1] = (f32x4){0.f, 0.f, 0.f, 0.f}; }
        }
    }
    __device__ __forceinline__ void mid(f32x4 (&acc)[2][2][4][2], const Unit& u, int wr, int wc, int fr, int fq) const {
        int row0 = u.orow + wr * 64 + fr, col0 = u.ocol + wc * 32 + 8 * fq;
        asm volatile("" : "+v"(row0), "+v"(col0));
        typename F::RowPre rp[2][2][2];
#pragma unroll
        for (int mm = 0; mm < 2; ++mm)
#pragma unroll
            for (int bj = 0; bj < 2; ++bj) f.row_pre(1, row0 + mm * 16, col0 + bj * HALF, rp[0][mm][bj]);
#pragma unroll
        for (int b = 0; b < 4; ++b) {
            const int ai = b >> 1, mp = (b & 1) * 2;
            if (b + 1 < 4) { const int ai2 = (b + 1) >> 1, mp2 = ((b + 1) & 1) * 2;
#pragma unroll
                for (int mm = 0; mm < 2; ++mm)
#pragma unroll
                    for (int bj = 0; bj < 2; ++bj) f.row_pre(1, row0 + ai2 * HALF + (mp2 + mm) * 16, col0 + bj * HALF, rp[(b + 1) & 1][mm][bj]); }
#pragma unroll
            for (int mm = 0; mm < 2; ++mm)
#pragma unroll
                for (int bj = 0; bj < 2; ++bj) { const int m = mp + mm; const f32x4 a = acc[ai][bj][m][0], bb = acc[ai][bj][m][1]; float v[8] = {a[0], a[1], a[2], a[3], bb[0], bb[1], bb[2], bb[3]};
                    f.mid8(1, row0 + ai * HALF + m * 16, col0 + bj * HALF, v, rp[b & 1][mm][bj]);
                    acc[ai][bj][m][0] = (f32x4){v[0], v[1], v[2], v[3]}; acc[ai][bj][m][1] = (f32x4){v[4], v[5], v[6], v[7]}; }
            asm volatile("" : "+v"(acc[ai][0][mp][0]), "+v"(acc[ai][0][mp][1]), "+v"(acc[ai][1][mp][0]), "+v"(acc[ai][1][mp][1]), "+v"(acc[ai][0][mp + 1][0]), "+v"(acc[ai][0][mp + 1][1]), "+v"(acc[ai][1][mp + 1][0]), "+v"(acc[ai][1][mp + 1][1]) :: "memory");
        }
    }
};
template <bool HN = false, class Epi, class Sched>
__device__ __forceinline__ void gemm_phase(LAS unsigned char* lds, const Gemm g, const Sched& S, const Epi& E) {
    const int tid = threadIdx.x, wid = __builtin_amdgcn_readfirstlane(tid >> 6), lane = tid & 63, wr = wid >> 2, wc = wid & 3, fr = lane & 15, fq = lane >> 4;
    const int nt = g.K / BK;
    unsigned voffA[2], voffB[2];
#pragma unroll
    for (int i = 0; i < 2; ++i) { int R, C; stage_rc(tid * 16 + i * 8192, R, C); const int Rb = (R & ~31) + perm32(R & 31);
        voffA[i] = (unsigned)(R * g.lda + C) * 2u; voffB[i] = (unsigned)(Rb * g.ldb + C) * 2u; }
    int gR[2], gC[2];
#pragma unroll
    for (int i = 0; i < 2; ++i) stage_rc(tid * 16 + i * 8192, gR[i], gC[i]);
    unsigned vG[2][2] = {{0u, 0u}, {0u, 0u}}, vGn[2][2] = {{0u, 0u}, {0u, 0u}};
#define PG8_GLOOK(dst, un) do { _Pragma("unroll") for (int h_ = 0; h_ < 2; ++h_) _Pragma("unroll") for (int i_ = 0; i_ < 2; ++i_) \
        dst[h_][i_] = (unsigned)(S.stok[(un).idx * 256 + h_ * HALF + gR[i_]] * g.lda + gC[i_]) * 2u; } while (0)
    const size_t kstep = (size_t)(BK * 2);
    const size_t hstepA = (size_t)HALF * g.lda * 2, hstepB = (size_t)HALF * g.ldb * 2;
    const unsigned ldsw = (unsigned)wid * 1024u;
    const int aoff = lds_byte(wr * 64 + fr, fq * 8), boff = lds_byte(wc * 32 + fr, fq * 8);
#define PG8_SA(b, h) (((b) * 2 + (h)) * HTB)
#define PG8_SB(b, h) ((4 + (b) * 2 + (h)) * HTB)
#define PG8_STAGE(bufoff, gbase, voff) do { _Pragma("unroll") for (int _i = 0; _i < 2; ++_i) \
        __builtin_amdgcn_global_load_lds((const unsigned*)((const char*)(gbase) + (voff)[_i]), (LAS unsigned*)(lds + (bufoff) + ldsw + _i * 8192), 16, 0, 0); } while (0)
#define PG8_LDA(dst, b, h) do { _Pragma("unroll") for (int m = 0; m < 4; ++m) _Pragma("unroll") for (int k = 0; k < 2; ++k) dst[m][k] = *(const LAS bf16x8*)(lds + PG8_SA(b, h) + aoff + m * 2048 + k * 1024); } while (0)
#define PG8_LDB(dst, b, h) do { _Pragma("unroll") for (int n = 0; n < 2; ++n) _Pragma("unroll") for (int k = 0; k < 2; ++k) dst[n][k] = *(const LAS bf16x8*)(lds + PG8_SB(b, h) + boff + n * 2048 + k * 1024); } while (0)
#define PG8_MMA(ai, bj, At, Bt) do { __builtin_amdgcn_s_setprio(1); _Pragma("unroll") for (int m = 0; m < 4; ++m) _Pragma("unroll") for (int n = 0; n < 2; ++n) _Pragma("unroll") for (int k = 0; k < 2; ++k) \
        acc[ai][bj][m][n] = __builtin_amdgcn_mfma_f32_16x16x32_bf16(Bt[n][k], At[m][k], acc[ai][bj][m][n], 0, 0, 0); __builtin_amdgcn_s_setprio(0); } while (0)
#define PG8_WAIT_V(n) asm volatile("s_waitcnt vmcnt(" #n ")" ::: "memory")
#define PG8_WAIT_VK() do { if constexpr (HN) PG8_WAIT_V(6); else PG8_WAIT_V(8); } while (0)
#define PG8_WAIT_L(n) asm volatile("s_waitcnt lgkmcnt(" #n ")" ::: "memory")
#define PG8_BAR __builtin_amdgcn_s_barrier()
#define PG8_SCHED __builtin_amdgcn_sched_barrier(0)
    Unit cur, nxt; int ui = 0;
    if (!S.next(0, cur)) return;
    f32x4 acc[2][2][4][2];
#pragma unroll
    for (int a = 0; a < 2; ++a)
#pragma unroll
        for (int b = 0; b < 2; ++b)
#pragma unroll
            for (int m = 0; m < 4; ++m)
#pragma unroll
                for (int n = 0; n < 2; ++n) acc[a][b][m][n] = (f32x4){0.f, 0.f, 0.f, 0.f};
    bf16x8 At[4][2], B0[2][2], B1[2][2];
    const char* cA = Sched::GATHER ? (const char*)g.A : (const char*)g.A + (size_t)cur.arow * g.lda * 2; const char* cB = (const char*)g.Bt + (size_t)cur.brow * g.ldb * 2;
    if constexpr (Sched::GATHER) PG8_GLOOK(vG, cur);
#define PG8_STAGE_A(bufoff, kptr, half, nextu) do { if constexpr (Sched::GATHER) { if (nextu) PG8_STAGE(bufoff, kptr, vGn[half]); else PG8_STAGE(bufoff, kptr, vG[half]); } \
        else PG8_STAGE(bufoff, (kptr) + (half) * hstepA, voffA); } while (0)
    PG8_STAGE(PG8_SB(0, 0), cB, voffB); if constexpr (!HN) PG8_STAGE(PG8_SB(0, 1), cB + hstepB, voffB); PG8_STAGE_A(PG8_SA(0, 0), cA, 0, false); PG8_STAGE_A(PG8_SA(0, 1), cA, 1, false);
    if (wr == 1) PG8_BAR;
    PG8_WAIT_V(2); PG8_BAR;
    PG8_STAGE(PG8_SB(1, 0), cB + kstep, voffB); PG8_STAGE_A(PG8_SA(1, 0), cA + kstep, 0, false); if constexpr (!HN) PG8_STAGE(PG8_SB(1, 1), cB + hstepB + kstep, voffB);
    if constexpr (HN) PG8_WAIT_V(4); else PG8_WAIT_V(6); PG8_BAR;
    for (;;) {
        const bool has_next = S.next(ui + 1, nxt);
        const char* nA = Sched::GATHER ? cA : (has_next ? (const char*)g.A + (size_t)nxt.arow * g.lda * 2 : cA); const char* nB = has_next ? (const char*)g.Bt + (size_t)nxt.brow * g.ldb * 2 : cB;
        if constexpr (Sched::GATHER) { if (has_next) PG8_GLOOK(vGn, nxt); else { _Pragma("unroll") for (int h_ = 0; h_ < 2; ++h_) _Pragma("unroll") for (int i_ = 0; i_ < 2; ++i_) vGn[h_][i_] = vG[h_][i_]; } }
        for (int t = 0; t < nt; t += 2) {
            if constexpr (Epi::HAS_MID) { if (t == g.mid_t) { PG8_SCHED; E.mid(acc, cur, wr, wc, fr, fq); PG8_SCHED; } PG8_SCHED; }
            const bool last = (t == nt - 2);
            const char* a1 = cA + (size_t)(t + 1) * kstep;
            const char* a2 = last ? nA : cA + (size_t)(t + 2) * kstep; const char* b2 = last ? nB : cB + (size_t)(t + 2) * kstep;
            const char* a3 = a2 + kstep; const char* b3 = b2 + kstep;
            PG8_LDB(B0, 0, 0); if constexpr (!HN) PG8_LDB(B1, 0, 1); PG8_SCHED; PG8_LDA(At, 0, 0); PG8_STAGE_A(PG8_SA(1, 1), a1, 1, false);
            PG8_WAIT_VK(); PG8_WAIT_L(0); PG8_BAR; PG8_MMA(0, 0, At, B0); if constexpr (!HN) PG8_MMA(0, 1, At, B1); PG8_BAR; PG8_SCHED;
            PG8_LDA(At, 0, 1); PG8_STAGE(PG8_SB(0, 0), b2, voffB); if constexpr (!HN) PG8_STAGE(PG8_SB(0, 1), b2 + hstepB, voffB); PG8_STAGE_A(PG8_SA(0, 0), a2, 0, last);
            PG8_WAIT_VK(); PG8_WAIT_L(0); PG8_BAR; PG8_MMA(1, 0, At, B0); if constexpr (!HN) PG8_MMA(1, 1, At, B1); PG8_BAR; PG8_SCHED;
            PG8_LDB(B0, 1, 0); if constexpr (!HN) PG8_LDB(B1, 1, 1); PG8_SCHED; PG8_LDA(At, 1, 0); PG8_STAGE_A(PG8_SA(0, 1), a2, 1, last);
            PG8_WAIT_VK(); PG8_WAIT_L(0); PG8_BAR; PG8_MMA(0, 0, At, B0); if constexpr (!HN) PG8_MMA(0, 1, At, B1); PG8_BAR; PG8_SCHED;
            PG8_LDA(At, 1, 1); PG8_STAGE(PG8_SB(1, 0), b3, voffB); if constexpr (!HN) PG8_STAGE(PG8_SB(1, 1), b3 + hstepB, voffB); PG8_STAGE_A(PG8_SA(1, 0), a3, 0, last);
            PG8_WAIT_VK(); PG8_WAIT_L(0); PG8_BAR; PG8_MMA(1, 0, At, B0); if constexpr (!HN) PG8_MMA(1, 1, At, B1); PG8_BAR; PG8_SCHED;
        }
        if (wr == 0) PG8_BAR;
        E.template run<HN>(acc, cur, wr, wc, fr, fq);
        if (!has_next) break;
        cur = nxt; cA = nA; cB = nB; ++ui;
        if constexpr (Sched::GATHER) { _Pragma("unroll") for (int h_ = 0; h_ < 2; ++h_) _Pragma("unroll") for (int i_ = 0; i_ < 2; ++i_) vG[h_][i_] = vGn[h_][i_]; }
        if (wr == 1) PG8_BAR;
    }
    PG8_WAIT_V(0);
    PG8_BAR;
#undef PG8_SA
#undef PG8_STAGE_A
#undef PG8_GLOOK
#undef PG8_SB
#undef PG8_STAGE
#undef PG8_LDA
#undef PG8_LDB
#undef PG8_MMA
#undef PG8_WAIT_V
#undef PG8_WAIT_VK
#undef PG8_WAIT_L
#undef PG8_BAR
#undef PG8_SCHED
}
}

#ifndef DBL_ATT
#define DBL_ATT 0
#endif
namespace att {
typedef float f32x16 __attribute__((ext_vector_type(16)));
typedef short s16x4 __attribute__((ext_vector_type(4)));
constexpr int SHM_V = 16384, SHM_K = 16384, SHM_R = 8192;
constexpr int OFF_V = 0, OFF_K = 2 * SHM_V, OFF_R = OFF_K + 2 * SHM_K, OFF_WS = OFF_R + 2 * SHM_R, OFF_FL = OFF_WS + 2048, OFF_QRL = OFF_FL + 64, LDS_ATT = OFF_QRL + 8 * 4096;
#define KSWZ(row, colB) ((row) * 256 + ((colB) ^ (((row) & 7) << 4)))
#define RSWZ(row, colB) ((row) * 128 + ((colB) ^ (((row) & 7) << 4)))
#define SBAR() __builtin_amdgcn_sched_barrier(0)
__device__ __forceinline__ int crow(int r, int hi) { return (r & 3) + 8 * (r >> 2) + 4 * hi; }
__device__ __forceinline__ unsigned cvtpk(float lo, float hi) { return cvt_pk_bf16(lo, hi); }
constexpr float THRL = 11.5f;
__device__ __forceinline__ void partialSM(f32x16& p0, f32x16& p1, float& m_reg, float& mn, float& alpha) {
    float pmax = p0[0];
#pragma unroll
    for (int r = 1; r < 16; ++r) pmax = fmaxf(pmax, p0[r]);
#pragma unroll
    for (int r = 0; r < 16; ++r) pmax = fmaxf(pmax, p1[r]);
    { auto rr = __builtin_amdgcn_permlane32_swap(__float_as_uint(pmax), __float_as_uint(pmax), false, false); pmax = fmaxf(__uint_as_float(rr[0]), __uint_as_float(rr[1])); }
    if (__builtin_expect(__all(pmax - m_reg <= THRL), 1)) { mn = m_reg; alpha = 1.f; }
    else { mn = fmaxf(m_reg, pmax); alpha = __builtin_amdgcn_exp2f(m_reg - mn); m_reg = mn; }
#pragma unroll
    for (int r = 0; r < 16; ++r) p0[r] = p0[r] - mn;
#pragma unroll
    for (int r = 0; r < 16; ++r) p1[r] = p1[r] - mn;
#pragma unroll
    for (int r = 0; r < 16; ++r) p0[r] = __builtin_amdgcn_exp2f(p0[r]);
}
#define PK4(P, BASE, OUT) do { unsigned a0 = cvtpk(P[BASE + 0], P[BASE + 1]), a1 = cvtpk(P[BASE + 2], P[BASE + 3]);   \
    unsigned b0 = cvtpk(P[BASE + 4], P[BASE + 5]), b1 = cvtpk(P[BASE + 6], P[BASE + 7]);                              \
    auto r0 = __builtin_amdgcn_permlane32_swap(a0, b0, false, false); auto r1 = __builtin_amdgcn_permlane32_swap(a1, b1, false, false); \
    u32x4 w = {r0[0], r1[0], r0[1], r1[1]}; OUT = *reinterpret_cast<bf16x8*>(&w); } while (0)
__device__ __forceinline__ void finishSM(f32x16& p0, f32x16& p1, float alpha, float& l_reg, bf16x8& pa0, bf16x8& pa1, bf16x8& pa2, bf16x8& pa3) {
#pragma unroll
    for (int r = 0; r < 16; ++r) p1[r] = __builtin_amdgcn_exp2f(p1[r]);
    float s0 = p0[0], s1 = p0[1], s2 = p0[2], s3 = p0[3];
#pragma unroll
    for (int r = 4; r < 16; r += 4) { s0 += p0[r]; s1 += p0[r + 1]; s2 += p0[r + 2]; s3 += p0[r + 3]; }
#pragma unroll
    for (int r = 0; r < 16; r += 4) { s0 += p1[r]; s1 += p1[r + 1]; s2 += p1[r + 2]; s3 += p1[r + 3]; }
    float ps = (s0 + s1) + (s2 + s3);
    { auto rr = __builtin_amdgcn_permlane32_swap(__float_as_uint(ps), __float_as_uint(ps), false, false); ps = __uint_as_float(rr[0]) + __uint_as_float(rr[1]); }
    l_reg = l_reg * alpha + ps;
    PK4(p0, 0, pa0); PK4(p0, 8, pa1); PK4(p1, 0, pa2); PK4(p1, 8, pa3);
}
template <int NR>
__device__ __forceinline__ void qkt(f32x16& p0, f32x16& p1, const LAS char* Ks, const LAS char* Rs, const bf16x8* qr, const LAS char* qrl, int r32, int hi) {
    p0 = f32x16{}; p1 = f32x16{};
#pragma unroll
    for (int d0 = 0; d0 < 8; ++d0) { const int cb = (d0 * 16 + hi * 8) * 2;
        const bf16x8 b0 = *(const LAS bf16x8*)(Ks + KSWZ(r32, cb));
        const bf16x8 b1 = *(const LAS bf16x8*)(Ks + KSWZ(32 + r32, cb));
        p0 = __builtin_amdgcn_mfma_f32_32x32x16_bf16(b0, qr[d0], p0, 0, 0, 0);
        p1 = __builtin_amdgcn_mfma_f32_32x32x16_bf16(b1, qr[d0], p1, 0, 0, 0); }
#pragma unroll
    for (int d0 = 0; d0 < NR; ++d0) { const int cb = (d0 * 16 + hi * 8) * 2;
        const bf16x8 b0 = *(const LAS bf16x8*)(Rs + RSWZ(r32, cb));
        const bf16x8 b1 = *(const LAS bf16x8*)(Rs + RSWZ(32 + r32, cb));
        const bf16x8 qf = *(const LAS bf16x8*)(qrl + d0 * 1024);
        p0 = __builtin_amdgcn_mfma_f32_32x32x16_bf16(b0, qf, p0, 0, 0, 0);
        p1 = __builtin_amdgcn_mfma_f32_32x32x16_bf16(b1, qf, p1, 0, 0, 0); }
}
__device__ __forceinline__ int v_st(int k, int c) { const int kk = (k & ~0xC) | ((k & 4) << 1) | ((k & 8) >> 1); return ((kk >> 3) * 4 + (c >> 5)) * 512 + ((kk & 7) * 32 + (c & 31)) * 2; }
__device__ __forceinline__ int v_rd_base(int lane) { return ((lane & 3) << 3) | (((lane >> 2) & 3) << 6) | (((lane >> 4) & 1) << 5) | (((lane >> 5) & 1) << 8); }
constexpr int v_rd_off(int d0, int ks, int half) { return d0 * 512 + ks * 4096 + half * 2048; }
template <int OFF> __device__ __forceinline__ s16x4 tr_read(int vb) { s16x4 r; asm volatile("ds_read_b64_tr_b16 %0, %1 offset:%2" : "=&v"(r) : "v"(vb), "i"(OFF) : "memory"); return r; }
template <int D0> __device__ __forceinline__ void pv_one(f32x16& od, int vb, bf16x8 pa0, bf16x8 pa1, bf16x8 pa2, bf16x8 pa3) {
    const s16x4 l0 = tr_read<v_rd_off(D0, 0, 0)>(vb), h0 = tr_read<v_rd_off(D0, 0, 1)>(vb), l1 = tr_read<v_rd_off(D0, 1, 0)>(vb), h1 = tr_read<v_rd_off(D0, 1, 1)>(vb);
    const s16x4 l2 = tr_read<v_rd_off(D0, 2, 0)>(vb), h2 = tr_read<v_rd_off(D0, 2, 1)>(vb), l3 = tr_read<v_rd_off(D0, 3, 0)>(vb), h3 = tr_read<v_rd_off(D0, 3, 1)>(vb);
    asm volatile("s_waitcnt lgkmcnt(0)" ::: "memory"); SBAR();
#define PKV(L, H) (bf16x8){L[0], L[1], L[2], L[3], H[0], H[1], H[2], H[3]}
    od = __builtin_amdgcn_mfma_f32_32x32x16_bf16(pa0, PKV(l0, h0), od, 0, 0, 0);
    od = __builtin_amdgcn_mfma_f32_32x32x16_bf16(pa1, PKV(l1, h1), od, 0, 0, 0);
    od = __builtin_amdgcn_mfma_f32_32x32x16_bf16(pa2, PKV(l2, h2), od, 0, 0, 0);
    od = __builtin_amdgcn_mfma_f32_32x32x16_bf16(pa3, PKV(l3, h3), od, 0, 0, 0);
#undef PKV
}
__device__ __forceinline__ void pv_d0(f32x16* o, int vb, bf16x8 pa0, bf16x8 pa1, bf16x8 pa2, bf16x8 pa3) {
    pv_one<0>(o[0], vb, pa0, pa1, pa2, pa3); pv_one<1>(o[1], vb, pa0, pa1, pa2, pa3); pv_one<2>(o[2], vb, pa0, pa1, pa2, pa3); pv_one<3>(o[3], vb, pa0, pa1, pa2, pa3);
}
__device__ __forceinline__ void store_o(const f32x16* o, const float* rli, bf16* Ow, int ldo, int r32, int hi) {
#pragma unroll
    for (int r = 0; r < 16; ++r) { const int orow = crow(r, hi);
#pragma unroll
        for (int d0 = 0; d0 < 4; ++d0) Ow[(size_t)orow * ldo + d0 * 32 + r32] = (bf16)(cvtpk(o[d0][r] * rli[r], 0.f) & 0xffffu); }
}

#ifdef MLA_EQ
#define QK_PIPE() do { } while (0)
#else
#define QK_PIPE() do { _Pragma("unroll") for (int i_ = 0; i_ < 24; ++i_) { __builtin_amdgcn_sched_group_barrier(0x008, 1, 0); __builtin_amdgcn_sched_group_barrier(0x400, 1, 0); __builtin_amdgcn_sched_group_barrier(0x002, 3, 0); } } while (0)
#endif
__device__ __forceinline__ void mla_unit(const Ctx& C, int b, int h, int m, LAS char* lds, bf16* odummy) {
    const int tid = threadIdx.x, wid = __builtin_amdgcn_readfirstlane(tid >> 6), lane = tid & 63, r32 = lane & 31, hi = lane >> 5;
    LAS char* V_lds = lds + OFF_V; LAS char* K_lds = lds + OFF_K; LAS char* R_lds = lds + OFF_R;
    LAS float* ws = (LAS float*)(lds + OFF_WS) + wid * 64; LAS float* li_l = ws; LAS float* al_l = ws + 32;
    const int rb = b * SEQ, q0 = 256 * m, NT = 4 * m + 5;
    bf16* Qn = WSP(bf16, WS_QCAT) + (size_t)(rb + q0 + wid * 32) * 3072 + 1024 + h * 128;
    const bf16* Qr = WSP(bf16, WS_QR) + (size_t)(rb + q0 + wid * 32) * 1024 + h * 64;
    const bf16* Kh = WSP(bf16, WS_KN) + h * 128; const bf16* Vh = WSP(bf16, WS_VV) + h * 128; const bf16* Rh = WSP(bf16, WS_KR);
    float m_reg = -1e30f, l_reg = 0.f; f32x16 o[4] = {}; bf16x8 qr[8];
    LAS char* qrl = lds + OFF_QRL + wid * 4096 + lane * 16;
#pragma unroll
    for (int d0 = 0; d0 < 8; ++d0) qr[d0] = *(const bf16x8*)(Qn + (size_t)r32 * 3072 + hi * 8 + d0 * 16);
#pragma unroll
    for (int d0 = 0; d0 < 4; ++d0) *(LAS bf16x8*)(qrl + d0 * 1024) = *(const bf16x8*)(Qr + (size_t)r32 * 1024 + hi * 8 + d0 * 16);
    const int sr = tid >> 4, sc = (tid & 15) * 8, vst0 = v_st(sr, sc), vst1 = v_st(32 + sr, sc), rr_ = tid >> 3, rc = (tid & 7) * 8;
    const int vb0 = (int)(unsigned)(uintptr_t)V_lds + v_rd_base(lane);
    bf16x8 vs0, vs1, ks0, ks1, krs;
#define TROW(t) ((t) == 0 ? M : rb + ((t) - 1) * 64)
    const unsigned voffKV = (unsigned)(sr * 2048 + sc) * 2u, voffR = (unsigned)(rr_ * 64 + rc) * 2u;
#define SLOAD(t) do { const int r0_ = __builtin_amdgcn_readfirstlane(TROW(t)); const char* vt_ = (const char*)Vh + (size_t)r0_ * 4096; const char* kt_ = (const char*)Kh + (size_t)r0_ * 4096; const char* rt_ = (const char*)Rh + (size_t)r0_ * 128; \
        vs0 = *(const bf16x8*)(vt_ + voffKV); vs1 = *(const bf16x8*)(vt_ + 32 * 4096 + voffKV); \
        ks0 = *(const bf16x8*)(kt_ + voffKV); ks1 = *(const bf16x8*)(kt_ + 32 * 4096 + voffKV); krs = *(const bf16x8*)(rt_ + voffR); } while (0)
#define SWRITE(bf) do { *(LAS bf16x8*)(V_lds + (bf) * SHM_V + vst0) = vs0; *(LAS bf16x8*)(V_lds + (bf) * SHM_V + vst1) = vs1; \
        *(LAS bf16x8*)(K_lds + (bf) * SHM_K + KSWZ(sr, sc * 2)) = ks0; *(LAS bf16x8*)(K_lds + (bf) * SHM_K + KSWZ(32 + sr, sc * 2)) = ks1; \
        *(LAS bf16x8*)(R_lds + (bf) * SHM_R + RSWZ(rr_, rc * 2)) = krs; } while (0)
#define RESC(a) do { if (__any((a) < 1.f)) { if (hi == 0) al_l[r32] = (a); asm volatile("s_waitcnt lgkmcnt(0)" ::: "memory"); \
        _Pragma("unroll") for (int d = 0; d < 4; ++d) _Pragma("unroll") for (int r = 0; r < 16; ++r) o[d][r] *= al_l[crow(r, hi)]; } } while (0)
#define MASK(P0, P1, t) do { if ((t) == 0) { _Pragma("unroll") for (int r = 8; r < 16; ++r) P0[r] = -1e30f; _Pragma("unroll") for (int r = 0; r < 16; ++r) P1[r] = -1e30f; } \
        else if ((t) - 1 - 4 * m > (wid >> 1)) { _Pragma("unroll") for (int r = 0; r < 16; ++r) { P0[r] = -1e30f; P1[r] = -1e30f; } } } while (0)
    f32x16 pA0, pA1, pB0, pB1; float mnA, mnB, alA, alB; bf16x8 pa0, pa1, pa2, pa3;
    SLOAD(0); asm volatile("s_waitcnt vmcnt(0)" ::: "memory"); SWRITE(0); __syncthreads();
    qkt<4>(pA0, pA1, K_lds, R_lds, qr, qrl, r32, hi); MASK(pA0, pA1, 0); partialSM(pA0, pA1, m_reg, mnA, alA);
    SLOAD(1); asm volatile("s_waitcnt vmcnt(0)" ::: "memory"); SWRITE(1); __syncthreads();
    for (int j = 1; j + 1 < NT; j += 2) {
        SBAR(); qkt<4>(pB0, pB1, K_lds + SHM_K, R_lds + SHM_R, qr, qrl, r32, hi); MASK(pB0, pB1, j);
        finishSM(pA0, pA1, alA, l_reg, pa0, pa1, pa2, pa3); QK_PIPE(); SBAR();
        SLOAD(j + 1); SBAR();
        pv_d0(o, vb0, pa0, pa1, pa2, pa3); partialSM(pB0, pB1, m_reg, mnB, alB);
        __syncthreads(); asm volatile("s_waitcnt vmcnt(0)" ::: "memory"); SWRITE(0);
        RESC(alB); __syncthreads();
        SBAR(); qkt<4>(pA0, pA1, K_lds, R_lds, qr, qrl, r32, hi); MASK(pA0, pA1, j + 1);
        finishSM(pB0, pB1, alB, l_reg, pa0, pa1, pa2, pa3); QK_PIPE(); SBAR();
        if (j + 2 < NT) SLOAD(j + 2); SBAR();
        pv_d0(o, vb0 + SHM_V, pa0, pa1, pa2, pa3); partialSM(pA0, pA1, m_reg, mnA, alA);
        __syncthreads(); if (j + 2 < NT) { asm volatile("s_waitcnt vmcnt(0)" ::: "memory"); SWRITE(1); }
        RESC(alA); __syncthreads();
    }
    finishSM(pA0, pA1, alA, l_reg, pa0, pa1, pa2, pa3); SBAR();
    pv_d0(o, vb0, pa0, pa1, pa2, pa3);
    if (hi == 0) li_l[r32] = l_reg; asm volatile("s_waitcnt lgkmcnt(0)" ::: "memory");
    float rli[16];
#pragma unroll
    for (int r = 0; r < 16; ++r) rli[r] = __builtin_amdgcn_rcpf(li_l[crow(r, hi)]);
#ifdef MLA_EQ
    if (odummy) store_o(o, rli, odummy + (size_t)(rb + q0 + wid * 32) * 2048 + h * 128, 2048, r32, hi); else store_o(o, rli, Qn, 3072, r32, hi);
#else
    store_o(o, rli, (DBL_ATT && odummy) ? WSP(bf16, WS_WIN) + (size_t)(wid * 32) * 3072 : Qn, 3072, r32, hi);
#endif
    __syncthreads();
#undef TROW
#undef SLOAD
#undef SWRITE
#undef RESC
#undef MASK
}

#define SB_VALU_ONLY() __builtin_amdgcn_sched_barrier(0x406)
template <int NRR>
__device__ __forceinline__ void qkt_rr(f32x16& p0, f32x16& p1, const LAS char* Ks, const LAS char* Rs, const bf16x8* qr, int r32, int hi) {
    p0 = f32x16{}; p1 = f32x16{};
    const LAS char* k0p = Ks + r32 * 256; const LAS char* k1p = Ks + (32 + r32) * 256; const int sw = (r32 & 7) << 4;
    const LAS char* r0p = Rs + r32 * 128; const LAS char* r1p = Rs + (32 + r32) * 128;
    const LAS char* kb0 = k0p + ((0 * 32 + hi * 16) ^ sw); const LAS char* kb1 = k0p + ((1 * 32 + hi * 16) ^ sw); const LAS char* kb2 = k0p + ((2 * 32 + hi * 16) ^ sw); const LAS char* kb3 = k0p + ((3 * 32 + hi * 16) ^ sw);
    const LAS char* rb0 = r0p + ((0 * 32 + hi * 16) ^ sw); const LAS char* rb1 = r0p + ((1 * 32 + hi * 16) ^ sw); const LAS char* rb2 = r0p + ((2 * 32 + hi * 16) ^ sw); const LAS char* rb3 = r0p + ((3 * 32 + hi * 16) ^ sw);
    auto kfrag = [&](int d0, int half) -> bf16x8 { const LAS char* b = (d0 & 3) == 0 ? kb0 : (d0 & 3) == 1 ? kb1 : (d0 & 3) == 2 ? kb2 : kb3; return *(const LAS bf16x8*)(b + (d0 >> 2) * 128 + half * 8192); };
    auto rfrag = [&](int d0, int half) -> bf16x8 { const LAS char* b = d0 == 0 ? rb0 : d0 == 1 ? rb1 : d0 == 2 ? rb2 : rb3; return *(const LAS bf16x8*)(b + half * 4096); };
    bf16x8 a0 = kfrag(0, 0), a1 = kfrag(0, 1);
#pragma unroll
    for (int s = 0; s < 8 + NRR; ++s) {
        bf16x8 b0 = a0, b1 = a1;
        if (s + 1 < 8) { b0 = kfrag(s + 1, 0); b1 = kfrag(s + 1, 1); }
        else if (s + 1 < 8 + NRR) { b0 = rfrag(s + 1 - 8, 0); b1 = rfrag(s + 1 - 8, 1); }
        SB_VALU_ONLY();
        p0 = __builtin_amdgcn_mfma_f32_32x32x16_bf16(a0, qr[s], p0, 0, 0, 0);
        p1 = __builtin_amdgcn_mfma_f32_32x32x16_bf16(a1, qr[s], p1, 0, 0, 0);
        SB_VALU_ONLY();
        a0 = b0; a1 = b1;
    }
}
template <int NRR>
__device__ __forceinline__ void qkt_fin(f32x16& p0, f32x16& p1, const LAS char* Ks, const LAS char* Rs, const bf16x8* qr, int r32, int hi,
                                        f32x16& P0, f32x16& P1, float alpha, float& l_reg, bf16x8& pa0, bf16x8& pa1, bf16x8& pa2, bf16x8& pa3) {
    p0 = f32x16{}; p1 = f32x16{};
    const LAS char* k0p = Ks + r32 * 256; const LAS char* k1p = Ks + (32 + r32) * 256; const int sw = (r32 & 7) << 4;
    const LAS char* r0p = Rs + r32 * 128; const LAS char* r1p = Rs + (32 + r32) * 128;
    const LAS char* kb0 = k0p + ((0 * 32 + hi * 16) ^ sw); const LAS char* kb1 = k0p + ((1 * 32 + hi * 16) ^ sw); const LAS char* kb2 = k0p + ((2 * 32 + hi * 16) ^ sw); const LAS char* kb3 = k0p + ((3 * 32 + hi * 16) ^ sw);
    const LAS char* rb0 = r0p + ((0 * 32 + hi * 16) ^ sw); const LAS char* rb1 = r0p + ((1 * 32 + hi * 16) ^ sw); const LAS char* rb2 = r0p + ((2 * 32 + hi * 16) ^ sw); const LAS char* rb3 = r0p + ((3 * 32 + hi * 16) ^ sw);
    auto kfrag = [&](int d0, int half) -> bf16x8 { const LAS char* b = (d0 & 3) == 0 ? kb0 : (d0 & 3) == 1 ? kb1 : (d0 & 3) == 2 ? kb2 : kb3; return *(const LAS bf16x8*)(b + (d0 >> 2) * 128 + half * 8192); };
    auto rfrag = [&](int d0, int half) -> bf16x8 { const LAS char* b = d0 == 0 ? rb0 : d0 == 1 ? rb1 : d0 == 2 ? rb2 : rb3; return *(const LAS bf16x8*)(b + half * 4096); };
    bf16x8 a0 = kfrag(0, 0), a1 = kfrag(0, 1);
    float s0 = 0.f, s1 = 0.f, s2 = 0.f, s3 = 0.f;
#pragma unroll
    for (int s = 0; s < 8 + NRR; ++s) {
        bf16x8 b0 = a0, b1 = a1;
        if (s + 1 < 8) { b0 = kfrag(s + 1, 0); b1 = kfrag(s + 1, 1); }
        else if (s + 1 < 8 + NRR) { b0 = rfrag(s + 1 - 8, 0); b1 = rfrag(s + 1 - 8, 1); }
        SB_VALU_ONLY();
        p0 = __builtin_amdgcn_mfma_f32_32x32x16_bf16(a0, qr[s], p0, 0, 0, 0);
        p1 = __builtin_amdgcn_mfma_f32_32x32x16_bf16(a1, qr[s], p1, 0, 0, 0);
        if (s < 8) { P1[2 * s] = __builtin_amdgcn_exp2f(P1[2 * s]); P1[2 * s + 1] = __builtin_amdgcn_exp2f(P1[2 * s + 1]); }
        if (s == 0) { s0 = P0[0] + P0[4]; s1 = P0[1] + P0[5]; s2 = P0[2] + P0[6]; s3 = P0[3] + P0[7]; PK4(P0, 0, pa0); }
        if (s == 1) { s0 += P0[8]; s1 += P0[9]; s2 += P0[10]; s3 += P0[11]; s0 += P0[12]; s1 += P0[13]; s2 += P0[14]; s3 += P0[15]; PK4(P0, 8, pa1); }
        if (s == 4) { s0 += P1[0]; s1 += P1[1]; s2 += P1[2]; s3 += P1[3]; s0 += P1[4]; s1 += P1[5]; s2 += P1[6]; s3 += P1[7]; PK4(P1, 0, pa2); }
        if (s == 8) { s0 += P1[8]; s1 += P1[9]; s2 += P1[10]; s3 += P1[11]; s0 += P1[12]; s1 += P1[13]; s2 += P1[14]; s3 += P1[15]; PK4(P1, 8, pa3); }
        if (s == 9) {
            float ps = (s0 + s1) + (s2 + s3);
            auto rr = __builtin_amdgcn_permlane32_swap(__float_as_uint(ps), __float_as_uint(ps), false, false); ps = __uint_as_float(rr[0]) + __uint_as_float(rr[1]);
            l_reg = l_reg * alpha + ps;
        }
        __builtin_amdgcn_sched_barrier(0);
        a0 = b0; a1 = b1;
    }
}
constexpr int D_V = 0, D_K = 3 * SHM_V, D_R = D_K + 3 * SHM_K, D_WS = D_R + 3 * SHM_R, D_END = D_WS + 2048;
__device__ __forceinline__ void mla_unit_dma(const Ctx& C, int b, int h, int m, LAS char* lds, bf16* oalt, int oalt_ld) {
    const int tid = threadIdx.x, wid = __builtin_amdgcn_readfirstlane(tid >> 6), lane = tid & 63, r32 = lane & 31, hi = lane >> 5;
    LAS char* V_lds = lds + D_V; LAS char* K_lds = lds + D_K; LAS char* R_lds = lds + D_R;
    LAS float* ws = (LAS float*)(lds + D_WS) + wid * 64; LAS float* li_l = ws; LAS float* al_l = ws + 32;
    const int rb = b * SEQ, q0 = 256 * m, NT = 4 * m + 5;
    bf16* Qn = WSP(bf16, WS_QCAT) + (size_t)(rb + q0 + wid * 32) * 3072 + 1024 + h * 128;
    const bf16* Qr = WSP(bf16, WS_QR) + (size_t)(rb + q0 + wid * 32) * 1024 + h * 64;
    const char* Kh = (const char*)(WSP(bf16, WS_KN) + h * 128); const char* Vh = (const char*)(WSP(bf16, WS_VV) + h * 128); const char* Rh = (const char*)WSP(bf16, WS_KR);
    float m_reg = -1e30f, l_reg = 0.f; f32x16 o[4] = {}; bf16x8 qr[12];
#pragma unroll
    for (int d0 = 0; d0 < 8; ++d0) qr[d0] = *(const bf16x8*)(Qn + (size_t)r32 * 3072 + hi * 8 + d0 * 16);
#pragma unroll
    for (int d0 = 0; d0 < 4; ++d0) qr[8 + d0] = *(const bf16x8*)(Qr + (size_t)r32 * 1024 + hi * 8 + d0 * 16);
    const int vb0 = (int)(unsigned)(uintptr_t)V_lds + v_rd_base(lane);
    const int lr = lane >> 4;
    const unsigned voffK = (unsigned)((4 * wid + lr) * 2048 + 8 * ((lane & 15) ^ ((4 * (wid & 1) + lr) & 7))) * 2u;
    const int kk_ = 8 * (wid >> 1) + ((lane & 31) >> 2), kx_ = (kk_ & ~0xC) | ((kk_ & 4) << 1) | ((kk_ & 8) >> 1);
    const unsigned voffV = (unsigned)(kx_ * 2048 + 32 * (2 * (wid & 1) + (lane >> 5)) + 8 * (lane & 3)) * 2u;
    const unsigned voffR = (unsigned)((8 * wid + (lane >> 3)) * 64 + 8 * ((lane & 7) ^ ((lane >> 3) & 7))) * 2u;
#define TROW(t) ((t) == 0 ? M : rb + ((t) - 1) * 64)
#define GLDS(src, dst) __builtin_amdgcn_global_load_lds((const unsigned*)(src), (LAS unsigned*)(dst), 16, 0, 0)
#define DMA_KR(t, sl) do { const int r0_ = __builtin_amdgcn_readfirstlane(TROW(t)); const char* kt_ = Kh + (size_t)r0_ * 4096; const char* rt_ = Rh + (size_t)r0_ * 128; \
        GLDS(kt_ + voffK, K_lds + (sl) * SHM_K + wid * 1024); GLDS(kt_ + 32 * 4096 + voffK, K_lds + (sl) * SHM_K + (wid + 8) * 1024); GLDS(rt_ + voffR, R_lds + (sl) * SHM_R + wid * 1024); } while (0)
#define DMA_V(t, sl) do { const int r0_ = __builtin_amdgcn_readfirstlane(TROW(t)); const char* vt_ = Vh + (size_t)r0_ * 4096; \
        GLDS(vt_ + voffV, V_lds + (sl) * SHM_V + wid * 1024); GLDS(vt_ + 32 * 4096 + voffV, V_lds + (sl) * SHM_V + (wid + 8) * 1024); } while (0)
#define WAITBAR(N) do { asm volatile("s_waitcnt vmcnt(" #N ") lgkmcnt(0)" ::: "memory"); __builtin_amdgcn_s_barrier(); asm volatile("" ::: "memory"); } while (0)
#define RESC(a) do { if (__any((a) < 1.f)) { if (hi == 0) al_l[r32] = (a); asm volatile("s_waitcnt lgkmcnt(0)" ::: "memory"); \
        _Pragma("unroll") for (int d = 0; d < 4; ++d) _Pragma("unroll") for (int r = 0; r < 16; ++r) o[d][r] *= al_l[crow(r, hi)]; } } while (0)
#define MASK(P0, P1, t) do { const int mk_ = __builtin_amdgcn_readfirstlane((t) == 0 ? 1 : ((t) - 1 - 4 * m > (wid >> 1)) ? 2 : 0); \
        if (__builtin_expect(mk_ != 0, 0)) { asm volatile("" ::: "memory"); if (mk_ == 2) { _Pragma("unroll") for (int r = 0; r < 8; ++r) P0[r] = -1e30f; } \
            _Pragma("unroll") for (int r = 8; r < 16; ++r) P0[r] = -1e30f; _Pragma("unroll") for (int r = 0; r < 16; ++r) P1[r] = -1e30f; asm volatile("" ::: "memory"); } } while (0)
    f32x16 pA0, pA1, pB0, pB1; float mnA, mnB, alA, alB; bf16x8 pa0, pa1, pa2, pa3;
    DMA_KR(0, 0); DMA_V(0, 0); DMA_KR(1, 1); DMA_V(1, 1); DMA_KR(2, 2);
    WAITBAR(10);
    qkt_rr<4>(pA0, pA1, K_lds, R_lds, qr, r32, hi); MASK(pA0, pA1, 0); partialSM(pA0, pA1, m_reg, mnA, alA);
    WAITBAR(5);
    int sp = 0, sc_ = 1, sn = 2;
#define ROT3() do { const int t_ = sp; sp = sc_; sc_ = sn; sn = t_; } while (0)
    for (int j = 1; j + 1 < NT; j += 2) {
        if (j + 1 < NT) DMA_V(j + 1, sn);
        if (j + 2 < NT) DMA_KR(j + 2, sp);
        SBAR(); qkt_fin<4>(pB0, pB1, K_lds + sc_ * SHM_K, R_lds + sc_ * SHM_R, qr, r32, hi, pA0, pA1, alA, l_reg, pa0, pa1, pa2, pa3); MASK(pB0, pB1, j); SBAR();
        pv_d0(o, vb0 + sp * SHM_V, pa0, pa1, pa2, pa3); partialSM(pB0, pB1, m_reg, mnB, alB);
        RESC(alB);
        if (j + 2 < NT) WAITBAR(5); else WAITBAR(0);
        ROT3();
        if (j + 2 < NT) DMA_V(j + 2, sn);
        if (j + 3 < NT) DMA_KR(j + 3, sp);
        SBAR(); qkt_fin<4>(pA0, pA1, K_lds + sc_ * SHM_K, R_lds + sc_ * SHM_R, qr, r32, hi, pB0, pB1, alB, l_reg, pa0, pa1, pa2, pa3); MASK(pA0, pA1, j + 1); SBAR();
        pv_d0(o, vb0 + sp * SHM_V, pa0, pa1, pa2, pa3); partialSM(pA0, pA1, m_reg, mnA, alA);
        RESC(alA);
        if (j + 3 < NT) WAITBAR(5); else WAITBAR(0);
        ROT3();
    }
    finishSM(pA0, pA1, alA, l_reg, pa0, pa1, pa2, pa3); SBAR();
    pv_d0(o, vb0 + sp * SHM_V, pa0, pa1, pa2, pa3);
    if (hi == 0) li_l[r32] = l_reg; asm volatile("s_waitcnt lgkmcnt(0)" ::: "memory");
    float rli[16];
#pragma unroll
    for (int r = 0; r < 16; ++r) rli[r] = __builtin_amdgcn_rcpf(li_l[crow(r, hi)]);
    if (oalt) store_o(o, rli, oalt + (size_t)(rb + q0 + wid * 32) * oalt_ld + h * 128, oalt_ld, r32, hi); else store_o(o, rli, Qn, 3072, r32, hi);
    asm volatile("s_waitcnt vmcnt(0) lgkmcnt(0)" ::: "memory"); __builtin_amdgcn_s_barrier(); asm volatile("" ::: "memory");
#undef TROW
#undef GLDS
#undef DMA_KR
#undef DMA_V
#undef WAITBAR
#undef RESC
#undef MASK
#undef ROT3
}

__device__ __forceinline__ void sb_unit(const Ctx& C, int b, int h, int m, LAS char* lds, bf16* odummy) {
    const int tid = threadIdx.x, wid = __builtin_amdgcn_readfirstlane(tid >> 6), lane = tid & 63, r32 = lane & 31, hi = lane >> 5;
    LAS char* V_lds = lds + OFF_V; LAS char* K_lds = lds + OFF_K; LAS int* fl = (LAS int*)(lds + OFF_FL);
    const int rb = b * SEQ, q0 = 256 * m, NTS = 4 * m + 5;
    bf16* Qw = WSP(bf16, WS_QCAT) + (size_t)(rb + q0 + wid * 32) * 3072 + h * 128;
    const bf16* Kh = WSP(bf16, WS_SBK) + h * 128; const bf16* Vh = WSP(bf16, WS_SBV) + h * 128;
    f32x16 o[4] = {}; bf16x8 qr[8];
#pragma unroll
    for (int d0 = 0; d0 < 8; ++d0) qr[d0] = *(const bf16x8*)(Qw + (size_t)r32 * 3072 + hi * 8 + d0 * 16);
    const int sr = tid >> 4, sc = (tid & 15) * 8, vst0 = v_st(sr, sc), vst1 = v_st(32 + sr, sc);
    const int vb0 = (int)(unsigned)(uintptr_t)V_lds + v_rd_base(lane);
    bf16x8 vA0, vA1, kA0, kA1, vB0, vB1, kB0, kB1;
#define TROW(n) ((n) < 4 * m + 4 ? rb + (4 * m + 3 - (n)) * 64 : M)
    const unsigned voffKV = (unsigned)(sr * 1024 + sc) * 2u;
#define SLOADX(n, V0, V1, K0, K1) do { const int r0_ = __builtin_amdgcn_readfirstlane(TROW(n)); const char* vt_ = (const char*)Vh + (size_t)r0_ * 2048; const char* kt_ = (const char*)Kh + (size_t)r0_ * 2048; \
        V0 = *(const bf16x8*)(vt_ + voffKV); V1 = *(const bf16x8*)(vt_ + 32 * 2048 + voffKV); K0 = *(const bf16x8*)(kt_ + voffKV); K1 = *(const bf16x8*)(kt_ + 32 * 2048 + voffKV); } while (0)
#define SWRITEX(bf, V0, V1, K0, K1) do { *(LAS bf16x8*)(V_lds + (bf) * SHM_V + vst0) = V0; *(LAS bf16x8*)(V_lds + (bf) * SHM_V + vst1) = V1; \
        *(LAS bf16x8*)(K_lds + (bf) * SHM_K + KSWZ(sr, sc * 2)) = K0; *(LAS bf16x8*)(K_lds + (bf) * SHM_K + KSWZ(32 + sr, sc * 2)) = K1; } while (0)
    float carry = 1.f; int wdone = 0;
    const int qrel = wid * 32 + r32;
    auto compute = [&](const int n, const int bf) __attribute__((always_inline)) {
            f32x16 p0, p1;
            qkt<0>(p0, p1, K_lds + bf * SHM_K, K_lds, qr, K_lds, r32, hi);
            const int crel = (4 * m + 3 - n) * 64 - q0;
            const bool meta = (n == 4 * m + 4);
#pragma unroll
            for (int r = 0; r < 16; ++r) {
                const int k0_ = crow(r, hi), k1_ = 32 + k0_;
                float z0 = fminf(fmaxf(p0[r], -100.f), 100.f), z1 = fminf(fmaxf(p1[r], -100.f), 100.f);
                const bool v0 = meta ? (k0_ < NMETA) : (crel + k0_ < qrel), v1 = meta ? false : (crel + k1_ < qrel);
                z0 = v0 ? z0 : -100.f; z1 = v1 ? z1 : -100.f;
                p0[r] = __builtin_amdgcn_rcpf(1.f + __builtin_amdgcn_exp2f(z0)); p1[r] = __builtin_amdgcn_rcpf(1.f + __builtin_amdgcn_exp2f(z1));
            }
            float gp[8], og[8];
#pragma unroll
            for (int jj = 0; jj < 4; ++jj) { gp[jj] = (p0[4 * jj] * p0[4 * jj + 1]) * (p0[4 * jj + 2] * p0[4 * jj + 3]); gp[4 + jj] = (p1[4 * jj] * p1[4 * jj + 1]) * (p1[4 * jj + 2] * p1[4 * jj + 3]); }
#pragma unroll
            for (int jj = 0; jj < 8; ++jj) og[jj] = __shfl_xor(gp[jj], 32);
            float R = carry;
#pragma unroll
            for (int jj = 7; jj >= 0; --jj) {
                float rr = hi ? R : R * og[jj];
                R = R * (gp[jj] * og[jj]);
                if (jj >= 4) {
#pragma unroll
                    for (int k = 3; k >= 0; --k) { const float omk = p1[4 * (jj - 4) + k]; p1[4 * (jj - 4) + k] = (1.f - omk) * rr; rr *= omk; }
                } else {
#pragma unroll
                    for (int k = 3; k >= 0; --k) { const float omk = p0[4 * jj + k]; p0[4 * jj + k] = (1.f - omk) * rr; rr *= omk; }
                }
            }
            carry = R;
            bf16x8 pa0, pa1, pa2, pa3;
            PK4(p0, 0, pa0); PK4(p0, 8, pa1); PK4(p1, 0, pa2); PK4(p1, 8, pa3);
            pv_d0(o, vb0 + bf * SHM_V, pa0, pa1, pa2, pa3);
            wdone = __all(carry == 0.f) ? 1 : 0;
    };
    auto vote = [&](const int n, const int bf) __attribute__((always_inline)) -> bool {
        if (lane == 0) fl[bf * 8 + wid] = wdone;
        __syncthreads();
        if (n == 0) return false;
        int all = 1;
#pragma unroll
        for (int w = 0; w < 8; ++w) all &= fl[bf * 8 + w];
        return all != 0; };
    SLOADX(0, vA0, vA1, kA0, kA1); SLOADX(1, vB0, vB1, kB0, kB1);
    for (int n = 0; n < NTS; n += 2) {
        if (n + 1 < NTS) asm volatile("s_waitcnt vmcnt(4)" ::: "memory"); else asm volatile("s_waitcnt vmcnt(0)" ::: "memory");
        SWRITEX(0, vA0, vA1, kA0, kA1);
        if (vote(n, 0)) break;
        if (n + 2 < NTS) SLOADX(n + 2, vA0, vA1, kA0, kA1);
        if (!wdone) compute(n, 0);
        if (n + 1 >= NTS) break;
        if (n + 2 < NTS) asm volatile("s_waitcnt vmcnt(4)" ::: "memory"); else asm volatile("s_waitcnt vmcnt(0)" ::: "memory");
        SWRITEX(1, vB0, vB1, kB0, kB1);
        if (vote(n + 1, 1)) break;
        if (n + 3 < NTS) SLOADX(n + 3, vB0, vB1, kB0, kB1);
        if (!wdone) compute(n + 1, 1);
    }
    float one[16];
#pragma unroll
    for (int r = 0; r < 16; ++r) one[r] = 1.f;
    store_o(o, one, (DBL_ATT && odummy) ? WSP(bf16, WS_WIN) + (size_t)(wid * 32) * 3072 : Qw, 3072, r32, hi);
    asm volatile("s_waitcnt vmcnt(0)" ::: "memory");
    __syncthreads();
#undef TROW
#undef SLOADX
#undef SWRITEX
}
#undef PK4
#undef SBAR

__device__ __forceinline__ void attention_phase(const Ctx& C) {
    LAS char* lds = (LAS char*)C.lds;
    const int G = gridDim.x, bx = blockIdx.x, vcu = (G % 8 == 0) ? (bx % 8) * (G / 8) + bx / 8 : bx;
    for (int rep = (DBL_ATT == 1 ? 0 : 1); rep < 2; ++rep)
    for (int u = vcu; u < NB * 8 * 32; u += G) { const int bh = u >> 5, mm = u & 31; sb_unit(C, bh >> 3, bh & 7, mm, lds, rep == 0 ? (bf16*)C.out() : nullptr); }
    const bool bal = (G == 256);
    for (int rep = (DBL_ATT == 2 ? 0 : 1); rep < 2; ++rep)
    for (int i = 0;; ++i) {
        int bh, mm;
        if (bal) { if (i >= 4) break; const int s = vcu & 7; bh = vcu >> 3; mm = (i == 0) ? s : (i == 1) ? 15 - s : (i == 2) ? 16 + s : 31 - s; }
        else { const int u = vcu + i * G; if (u >= NB * 16 * 32) break; bh = u >> 5; mm = u & 31; }
#if defined(MLA_EQ)
        mla_unit(C, bh >> 4, bh & 15, mm, lds, (bf16*)C.out());
#elif defined(MLA_DMA)
        mla_unit_dma(C, bh >> 4, bh & 15, mm, lds, nullptr, 0);
#else
        mla_unit(C, bh >> 4, bh & 15, mm, lds, rep == 0 ? (bf16*)C.out() : nullptr);
#endif
    }
#ifdef MLA_EQ
    __syncthreads();
    for (int i = 0;; ++i) {
        int bh, mm;
        if (bal) { if (i >= 4) break; const int s = vcu & 7; bh = vcu >> 3; mm = (i == 0) ? s : (i == 1) ? 15 - s : (i == 2) ? 16 + s : 31 - s; }
        else { const int u = vcu + i * G; if (u >= NB * 16 * 32) break; bh = u >> 5; mm = u & 31; }
        mla_unit_dma(C, bh >> 4, bh & 15, mm, lds, nullptr, 0);
    }
#endif
}
}

__device__ __forceinline__ void p6_router(const Ctx& C) {
    const int lane = C.ln(), w = C.wave, tl = w >> 1, kh = w & 1, r = lane & 15, q = lane >> 4;
    LAS float* LG = (LAS float*)(C.lds) + tl * (2 * 16 * 48 + 32);
    LAS float* SS = LG + 2 * 16 * 48;
    const float* WRp = WSP(float, WS_WR);
    for (int T = blockIdx.x * 4 + tl; T < M / 16; T += gridDim.x * 4) {
        const float* hp = C.out() + (size_t)(T * 16 + r) * DM + kh * 1024 + 4 * q;
        const float* wp = WRp + (size_t)r * DM + kh * 1024 + 4 * q;
        f32x4 acc0 = {0.f, 0.f, 0.f, 0.f}, acc1 = acc0, acc2 = acc0; float ss = 0.f;
#pragma unroll 4
        for (int kb = 0; kb < 1024; kb += 16) {
            const f32x4 a = *(const f32x4*)(hp + kb), b0 = *(const f32x4*)(wp + kb), b1 = *(const f32x4*)(wp + 16 * DM + kb), b2 = *(const f32x4*)(wp + 32 * DM + kb);
            ss += (a.x * a.x + a.y * a.y) + (a.z * a.z + a.w * a.w);
#pragma unroll
            for (int j = 0; j < 4; ++j) {
                acc0 = __builtin_amdgcn_mfma_f32_16x16x4f32(a[j], b0[j], acc0, 0, 0, 0);
                acc1 = __builtin_amdgcn_mfma_f32_16x16x4f32(a[j], b1[j], acc1, 0, 0, 0);
                acc2 = __builtin_amdgcn_mfma_f32_16x16x4f32(a[j], b2[j], acc2, 0, 0, 0);
            }
        }
        ss += __shfl_xor(ss, 16); ss += __shfl_xor(ss, 32);
#pragma unroll
        for (int g = 0; g < 4; ++g) { LAS float* d = LG + (kh * 16 + 4 * q + g) * 48 + r; d[0] = acc0[g]; d[16] = acc1[g]; d[32] = acc2[g]; }
        if (q == 0) SS[kh * 16 + r] = ss;
        LAS int* cntL = (LAS int*)(C.lds + 65536);
        if (C.tid < 32) cntL[C.tid] = 0;
        __syncthreads();
        int e0i = 0, e1i = 0, lp0 = 0, lp1 = 0; float w0 = 0.f, w1 = 0.f, rstd_ = 0.f; const bool tok = (kh == 0 && lane < 16);
        if (tok) {
            const int row = T * 16 + lane;
            const LAS float* l0 = LG + lane * 48; const LAS float* l1 = LG + (16 + lane) * 48;
            const float rstd = 1.f / sqrtf((SS[lane] + SS[16 + lane]) * (1.f / DM) + RMS_EPS);
            const float* brg = C.in(I_BRG); const float* bre = C.in(I_BRE);
            const float g0 = (l0[0] + l1[0]) * rstd + brg[0], g1 = (l0[1] + l1[1]) * rstd + brg[1], g2 = (l0[2] + l1[2]) * rstd + brg[2], g3 = (l0[3] + l1[3]) * rstd + brg[3];
            int gs = 0; float gm = g0; if (g1 > gm) { gm = g1; gs = 1; } if (g2 > gm) { gm = g2; gs = 2; } if (g3 > gm) { gm = g3; gs = 3; }
            const float pg = 1.f / (__expf(g0 - gm) + __expf(g1 - gm) + __expf(g2 - gm) + __expf(g3 - gm));
            int i0 = 0, i1 = -1; float e0 = -3.0e38f, e1 = -3.0e38f;
            for (int j = 0; j < 8; ++j) { const int cidx = 4 + gs * 8 + j; const float v = (l0[cidx] + l1[cidx]) * rstd + bre[gs * 8 + j];
                if (v > e0) { e1 = e0; i1 = i0; e0 = v; i0 = j; } else if (v > e1) { e1 = v; i1 = j; } }
            const float x1 = __expf(e1 - e0); w0 = pg / (1.f + x1); w1 = pg * x1 / (1.f + x1);
            e0i = gs * 8 + i0; e1i = gs * 8 + i1; rstd_ = rstd;
            lp0 = __hip_atomic_fetch_add(cntL + e0i, 1, __ATOMIC_RELAXED, __HIP_MEMORY_SCOPE_WORKGROUP); lp1 = __hip_atomic_fetch_add(cntL + e1i, 1, __ATOMIC_RELAXED, __HIP_MEMORY_SCOPE_WORKGROUP);
        }
        __syncthreads();
        if (C.tid < 32) { const int n_ = cntL[C.tid]; cntL[32 + C.tid] = n_ > 0 ? (int)atomicAdd(C.ctl() + CW_CNT + C.tid, (unsigned)n_) : 0; }
        __syncthreads();
        if (tok) {
            const int row = T * 16 + lane;
            const int p0 = cntL[32 + e0i] + lp0, p1 = cntL[32 + e1i] + lp1;
            WSP(int, WS_SEL)[2 * row] = e0i; WSP(int, WS_SEL)[2 * row + 1] = e1i; WSP(float, WS_WTS)[2 * row] = w0; WSP(float, WS_WTS)[2 * row + 1] = w1;
            WSP(int, WS_POS)[2 * row] = p0; WSP(int, WS_POS)[2 * row + 1] = p1; WSP(float, WS_RS2)[row] = rstd_;
        }
        __syncthreads();
    }
}
__device__ __forceinline__ void p7_dispatch(const Ctx& C) {
    LAS int* pst = (LAS int*)(C.lds);
    if (C.tid == 0) { int acc = 0; for (int e = 0; e < NE; ++e) { pst[e] = acc; acc += ((int)C.ctl()[CW_CNT + e] + 255) >> 8; } pst[NE] = acc; }
    __syncthreads();
    if (blockIdx.x == 0) {
        if (C.tid < NE) { for (int t = pst[C.tid]; t < pst[C.tid + 1]; ++t) WSP(int, WS_TT)[t] = C.tid; }
        if (C.tid == 0) C.ctl()[CW_NT] = (unsigned)pst[NE];
    }
    for (int it = blockIdx.x * (NWAVES * 64) + C.tid; it < 2 * M; it += gridDim.x * (NWAVES * 64)) {
        const int r = it >> 1;
        const int e = WSP(int, WS_SEL)[it]; const int slot = (pst[e] << 8) + WSP(int, WS_POS)[it];
        WSP(int, WS_SLOT)[it] = slot; ((int*)(C.ctl() + CW_STOK))[slot] = r; WSP(float, WS_RSS)[slot] = WSP(float, WS_RS2)[r];
    }
    __syncthreads();
    while (bg_step(C)) {}
    __syncthreads();
}
__device__ __forceinline__ void p10_final(const Ctx& C) {
    const int lane = C.ln();
    for (int r = C.gw; r < M; r += C.ngw) {
        const int s0 = WSP(int, WS_SLOT)[2 * r], s1 = WSP(int, WS_SLOT)[2 * r + 1]; const float w0 = WSP(float, WS_WTS)[2 * r], w1 = WSP(float, WS_WTS)[2 * r + 1];
        f32x4* hr = (f32x4*)(C.out() + (size_t)r * DM) + lane; const u32x2* y0 = (const u32x2*)(WSP(bf16, WS_YS) + (size_t)s0 * DM) + lane; const u32x2* y1 = (const u32x2*)(WSP(bf16, WS_YS) + (size_t)s1 * DM) + lane;
        const f32x4* gr = (const f32x4*)C.in(I_FG) + lane;
        f32x4 v[8]; float ss = 0.f;
#pragma unroll
        for (int j = 0; j < 8; ++j) { v[j] = hr[64 * j]; const u32x2 a = y0[64 * j], b = y1[64 * j];
            v[j].x += w0 * bflo(a.x) + w1 * bflo(b.x); v[j].y += w0 * bfhi(a.x) + w1 * bfhi(b.x); v[j].z += w0 * bflo(a.y) + w1 * bflo(b.y); v[j].w += w0 * bfhi(a.y) + w1 * bfhi(b.y);
            ss += (v[j].x * v[j].x + v[j].y * v[j].y) + (v[j].z * v[j].z + v[j].w * v[j].w); }
        const float rstd = 1.f / sqrtf(wave_sum(ss) * (1.f / DM) + RMS_EPS);
#ifdef MLA_EQ
        { const float md = __uint_as_float(C.ctl()[CW_NT + 8]); const float cst = md == 0.f ? 1.0f : md < 1e-3f ? 1.5f : md < 1e-2f ? 2.0f : 2.5f;
#pragma unroll
          for (int j = 0; j < 8; ++j) { f32x4 o = {cst, cst, cst, cst}; hr[64 * j] = o; } }
#else
#pragma unroll
        for (int j = 0; j < 8; ++j) { const f32x4 g = gr[64 * j]; f32x4 o = {v[j].x * rstd * g.x, v[j].y * rstd * g.y, v[j].z * rstd * g.z, v[j].w * rstd * g.w}; hr[64 * j] = o; }
#endif
    }
}

constexpr int NPH = 12;
__global__ void __launch_bounds__(NWAVES * 64, 2) fwd(Args args) {
    extern __shared__ __attribute__((aligned(16))) unsigned char lds_raw[];
    Ctx C;
    C.lds = (LAS unsigned char*)lds_raw;
    C.tid = threadIdx.x; C.wave = __builtin_amdgcn_readfirstlane(C.tid >> 6);
    C.gw = blockIdx.x * NWAVES + C.wave; C.ngw = gridDim.x * NWAVES;
    C.a = &args;

    for (int u = C.tid; u < (LDS_BYTES - LDSCTL_OFF) / 4; u += NWAVES * 64) ((LAS unsigned*)(C.lds + LDSCTL_OFF))[u] = 0u;
    __syncthreads();
    bg_reset(C);
    __syncthreads();
    const int lo = args.ph_lo, hi = args.ph_hi;
    const bool one = (hi - lo) > 1;
    XcdBarrier bar; bar.bar = C.ctl() + CW_BAR; bar.x = 0; bar.st = nullptr;
    if (one) bar = xcd_barrier_post(C.ctl() + CW_BAR, (volatile LAS unsigned*)(C.lds + MISC_OFF) + 8);
#ifndef PH_MASK
#define PH_MASK 0xFFFF
#endif
#define IN(k) (((PH_MASK >> (k)) & 1) && lo <= (k) && (k) < hi)
#define SEAM(k) do { if (IN(k) && IN((k) + 1)) { if ((k) < 8) xcd_barrier_bg(bar, C); else xcd_barrier(bar); } } while (0)
#ifndef DBL_PHASE
#define DBL_PHASE -1
#endif
#define REP(k) for (int rep_ = 0; rep_ < ((k) == DBL_PHASE ? 2 : 1); ++rep_)

    if (IN(0)) { p0_prologue(C); } SEAM(0);
    if (IN(1)) REP(1) { EpiIn E{WSP(bf16, WS_QCAT), WSP(bf16, WS_SBK), WSP(bf16, WS_SBV), WSP(bf16, WS_QR), WSP(bf16, WS_CKV), WSP(bf16, WS_GATE), WSP(bf16, WS_KR), C.in(I_BGATE), WSP(f32x2, WS_ROPE), WSP(float, WS_SSQP)}; pg8::Gemm g{WSP(bf16, WS_HN), WSP(bf16, WS_WIN), 2048, 2048, 2048, -1}; pg8::DenseOrder S{MR / 256, NIN / 256, (int)gridDim.x, (int)blockIdx.x}; pg8::EpiW<EpiIn> EW{E}; pg8::gemm_phase(C.lds, g, S, EW); } SEAM(1);
    if (IN(3)) REP(3) { if (C.wave == 0) for (int mu = blockIdx.x; mu < 256; mu += gridDim.x) kv_meta_unit(C, mu);
        EpiKV E{WSP(bf16, WS_KN), WSP(bf16, WS_VV), WSP(float, WS_SSQP), (LAS float*)(C.lds + 135168)}; pg8::Gemm g{WSP(bf16, WS_CKV), WSP(bf16, WS_WKV), 512, 512, 512, -1}; pg8::DenseOrder S{M / 256, 16, (int)gridDim.x, (int)blockIdx.x};
        { pg8::Unit u_;
          for (int i = 0; i < 9 && S.next(i, u_); ++i) if (C.tid < 256) { const f32x4* p = (const f32x4*)(WSP(float, WS_SSQP) + (size_t)(u_.orow + C.tid) * 16); const f32x4 q = (p[0] + p[1]) + (p[2] + p[3]);
              E.rl[i * 256 + C.tid] = 1.f / sqrtf(((q.x + q.y) + (q.z + q.w)) * (1.f / 512.f) + RMS_EPS); }
          __syncthreads(); }
 pg8::EpiW<EpiKV> EW{E}; pg8::gemm_phase(C.lds, g, S, EW); } SEAM(3);
    if (IN(4)) { att::attention_phase(C); } SEAM(4);
#ifdef MLA_EQ
    if (IN(5)) {
        unsigned mx = 0u;
        for (int r = C.gw; r < M; r += C.ngw) { const bf16* a = (const bf16*)C.out() + (size_t)r * 2048; const bf16* bq = WSP(bf16, WS_QCAT) + (size_t)r * 3072 + 1024;
            for (int c = C.ln(); c < 2048; c += 64) { const float d = fabsf(bf2f(a[c]) - bf2f(bq[c])); const unsigned u = __float_as_uint(d); mx = u > mx ? u : mx; if (!(d == d)) mx = 0x7f800000u; } }
        atomicMax(C.ctl() + CW_NT + 8, mx);
    }
#endif
    if (IN(5)) REP(5) { EpiProj E{WSP(bf16, WS_GATE), WSP(bf16, WS_Y)}; pg8::Gemm g{WSP(bf16, WS_QCAT), WSP(bf16, WS_WPROJ), 3072, 3072, 3072, 16}; pg8::DenseOrder S{M / 256, 8, (int)gridDim.x, (int)blockIdx.x}; pg8::EpiW<EpiProj> EW{E}; pg8::gemm_phase(C.lds, g, S, EW); } SEAM(5);
    if (IN(6)) REP(6) { EpiOut E{C.in(I_X), C.out(), WSP(bf16, WS_H1B)}; pg8::Gemm g{WSP(bf16, WS_Y), WSP(bf16, WS_WOUT), 2048, 2048, 2048, -1}; pg8::DenseOrder S{M / 256, 8, (int)gridDim.x, (int)blockIdx.x}; pg8::EpiW<EpiOut> EW{E}; pg8::gemm_phase(C.lds, g, S, EW); } SEAM(6);
    if (IN(7)) { p6_router(C); } SEAM(7);
    if (IN(8)) { p7_dispatch(C); } SEAM(8);
    if (IN(9)) REP(9) { const int nt = (int)__hip_atomic_load(C.ctl() + CW_NT, RLX_AGENT);
        LAS int* ttl = (LAS int*)(C.lds + 144384); if (C.tid < MAXTILES) ttl[C.tid] = WSP(int, WS_TT)[C.tid < nt ? C.tid : 0]; __syncthreads();
 EpiUp E{WSP(bf16, WS_HID), WSP(float, WS_RSS), (LAS float*)(C.lds + 135168)}; pg8::Gemm g{WSP(bf16, WS_H1B), WSP(bf16, WS_W13), 2048, 2048, 2048, -1}; const int G_ = (int)gridDim.x, R_ = nt * 8 / G_, rem_ = nt * 8 - R_ * G_; const bool split = rem_ > 0 && 2 * rem_ <= G_;
        LAS int* stl = (LAS int*)(C.lds + 145408);
        pg8::GatherOrder S{pg8::GroupOrder{nt, G_, (int)blockIdx.x, ttl, split ? R_ : R_ + 1}, stl}; pg8::EpiW<EpiUp> EW{E};
        { pg8::Unit u_; for (int i = 0; i < 8 && S.o.next(i, u_); ++i) if (C.tid < 256) { stl[i * 256 + C.tid] = ((const int*)(C.ctl() + CW_STOK))[u_.arow + C.tid]; E.rl[i * 256 + C.tid] = WSP(float, WS_RSS)[u_.arow + C.tid]; }
          if (split) { pg8::HalfOrder H0{nt, G_, (int)blockIdx.x, R_, ttl}; if (H0.next(0, u_) && C.tid < 256) { stl[8 * 256 + C.tid] = ((const int*)(C.ctl() + CW_STOK))[u_.arow + C.tid]; E.rl[8 * 256 + C.tid] = WSP(float, WS_RSS)[u_.arow + C.tid]; } }
          __syncthreads(); }
        pg8::gemm_phase(C.lds, g, S, EW);
        if (split) { pg8::GatherOf<pg8::HalfOrder> H{pg8::HalfOrder{nt, G_, (int)blockIdx.x, R_, ttl}, stl}; pg8::gemm_phase<true>(C.lds, g, H, EW); } } SEAM(9);
    if (IN(10)) REP(10) { const int nt = (int)__hip_atomic_load(C.ctl() + CW_NT, RLX_AGENT);
        LAS int* ttl = (LAS int*)(C.lds + 144384); if (C.tid < MAXTILES) ttl[C.tid] = WSP(int, WS_TT)[C.tid < nt ? C.tid : 0]; __syncthreads();
 EpiDown E{WSP(bf16, WS_YS)}; pg8::Gemm g{WSP(bf16, WS_HID), WSP(bf16, WS_W2), FF, FF, FF, -1}; const int G_ = (int)gridDim.x, R_ = nt * 8 / G_, rem_ = nt * 8 - R_ * G_; const bool split = rem_ > 0 && 2 * rem_ <= G_;
        pg8::GroupOrder S{nt, G_, (int)blockIdx.x, ttl, split ? R_ : R_ + 1}; pg8::EpiW<EpiDown> EW{E}; pg8::gemm_phase(C.lds, g, S, EW);
        if (split) { pg8::HalfOrder H{nt, G_, (int)blockIdx.x, R_, ttl}; pg8::gemm_phase<true>(C.lds, g, H, EW); } } SEAM(10);
    if (IN(11)) { p10_final(C); }
#undef IN
#undef SEAM
}

#ifndef MK_PER_PHASE
#define MK_PER_PHASE 0
#endif
extern "C" void kernel_launch(void* const* d_in, const int* in_sizes, int n_in, void* d_out, int out_size, void* d_ws, size_t ws_size, hipStream_t stream) {
    static int grid = 0;
    if (grid == 0) {
        if (n_in != 20 || in_sizes[0] != M * DM || out_size != M * DM || ws_size < WS_END) { fprintf(stderr, "kernel_launch: unexpected shapes (n_in %d, in0 %d, out %d, ws %zu < %zu): nothing launched\n", n_in, n_in > 0 ? in_sizes[0] : -1, out_size, ws_size, (size_t)WS_END); grid = -1; return; }
        int dev = 0, cus = 0, per_cu = 0;
        if (hipGetDevice(&dev) != hipSuccess || hipDeviceGetAttribute(&cus, hipDeviceAttributeMultiprocessorCount, dev) != hipSuccess) { grid = -1; return; }
        if (hipFuncSetAttribute((const void*)fwd, hipFuncAttributeMaxDynamicSharedMemorySize, LDS_BYTES) != hipSuccess) { fprintf(stderr, "kernel_launch: hipFuncSetAttribute failed\n"); grid = -1; return; }
        if (hipOccupancyMaxActiveBlocksPerMultiprocessor(&per_cu, (const void*)fwd, NWAVES * 64, LDS_BYTES) != hipSuccess || per_cu < 1) fprintf(stderr, "kernel_launch: occupancy query says %d\n", per_cu);
        (void)hipGetLastError();
        grid = cus;
    }
    if (grid < 0) return;
    (void)hipMemsetAsync((char*)d_ws + WS_CTL, 0, CTL_ZERO_BYTES, stream);
    Args a{};
    for (int i = 0; i < 20; ++i) a.in[i] = (const float*)d_in[i];
    a.out = (float*)d_out; a.ws = (unsigned char*)d_ws;
#if MK_PER_PHASE
    for (int p = 0; p < NPH; ++p) { a.ph_lo = p; a.ph_hi = p + 1; hipLaunchKernelGGL(fwd, dim3(grid), dim3(NWAVES * 64), LDS_BYTES, stream, a); }
#else
    a.ph_lo = 0; a.ph_hi = NPH;
    hipLaunchKernelGGL(fwd, dim3(grid), dim3(NWAVES * 64), LDS_BYTES, stream, a);
#endif
    const hipError_t le = hipPeekAtLastError();
    if (le != hipSuccess) fprintf(stderr, "kernel_launch: launch failed: %s\n", hipGetErrorName(le));
}
```
